# Optimizing an MI355X kernel written in HIP

```python
import math, functools
import jax, jax.numpy as jnp
from jax import lax
import numpy as np

D_MODEL = 1024
BATCH = 2
SEQ = 16384
DEPTH = 2
DEC_BATCH = 16
DEC_SEQ = 32
PAST_LEN = 4096

CHUNK = 64
Q_BLOCK = 128
N_MIXERS = 2
N_FOX = (DEPTH + 1) // 2
N_DIFF = DEPTH // 2
FOX_HEADS = 16
FOX_HD = D_MODEL // FOX_HEADS
DIFF_HEADS = 8
DIFF_HD = D_MODEL // DIFF_HEADS // 2
D_FF = -(-8 * D_MODEL // (3 * 256)) * 256
DEEPNORM_ALPHA = (2.0 * DEPTH) ** 0.25
DEEPNORM_BETA = (8.0 * DEPTH) ** -0.25
LN_EPS = 1e-5
NEG_INF = -1e30

kernel_name = 'fox_diffattn_deepnorm_streaming_step'


def _layernorm(x, g, b):
    xf = x.astype(jnp.float32)
    mu = jnp.mean(xf, axis=-1, keepdims=True)
    var = jnp.mean(jnp.square(xf - mu), axis=-1, keepdims=True)
    return ((xf - mu) * lax.rsqrt(var + LN_EPS) * g.astype(jnp.float32) + b.astype(jnp.float32)).astype(x.dtype)


def _sweep_queries(block_fn, q_pos, q_args, kv_args):
    t_q = q_pos.shape[0]
    if t_q <= Q_BLOCK:
        return block_fn(q_pos, *q_args, *kv_args)
    nb = t_q // Q_BLOCK

    def split(a):
        return jnp.moveaxis(a.reshape(a.shape[0], nb, Q_BLOCK, *a.shape[2:]), 1, 0)

    xs = (q_pos.reshape(nb, Q_BLOCK),) + tuple(split(a) for a in q_args)
    out = lax.map(lambda xb: block_fn(xb[0], *xb[1:], *kv_args), xs)
    out = jnp.moveaxis(out, 0, 1)
    return out.reshape(out.shape[0], t_q, *out.shape[3:])


def _fox_block(q_pos, q, f_q, k_pos, k, v, f_k):
    s = jnp.einsum('bqhd,bshd->bhqs', q, k, preferred_element_type=jnp.float32) * (FOX_HD ** -0.5)
    decay = jnp.transpose(f_q, (0, 2, 1))[:, :, :, None] - jnp.transpose(f_k, (0, 2, 1))[:, :, None, :]
    causal = k_pos[None, :] <= q_pos[:, None]
    s = jnp.where(causal, s + decay, NEG_INF)
    p = jax.nn.softmax(s, axis=-1)
    return jnp.einsum('bhqs,bshd->bqhd', p.astype(v.dtype), v)


def _fox_mixer(x, w_in, b_f, w_out, past_k=None, past_v=None, past_logf=None):
    b, t, _ = x.shape
    proj = x @ w_in
    q, k, v, fl = jnp.split(proj, [D_MODEL, 2 * D_MODEL, 3 * D_MODEL], axis=-1)
    q = q.reshape(b, t, FOX_HEADS, FOX_HD)
    k = k.reshape(b, t, FOX_HEADS, FOX_HD)
    v = v.reshape(b, t, FOX_HEADS, FOX_HD)
    logf = jax.nn.log_sigmoid((fl + b_f).astype(jnp.float32))
    if past_k is None:
        k_all, v_all, logf_all, offset = k, v, logf, 0
    else:
        offset = past_k.shape[1]
        k_all = jnp.concatenate([past_k, k], axis=1)
        v_all = jnp.concatenate([past_v, v], axis=1)
        logf_all = jnp.concatenate([past_logf.astype(jnp.float32), logf], axis=1)
    f_cum = jnp.cumsum(logf_all, axis=1)
    k_pos = jnp.arange(k_all.shape[1])
    q_pos = offset + jnp.arange(t)
    o = _sweep_queries(_fox_block, q_pos, (q, f_cum[:, offset:]), (k_pos, k_all, v_all, f_cum))
    y = o.reshape(b, t, D_MODEL) @ w_out
    return y, k, v, logf


def _diff_block(lam, q_pos, q, k_pos, k, v):
    q1, q2 = jnp.split(q, 2, axis=-1)
    k1, k2 = jnp.split(k, 2, axis=-1)
    slopes = jnp.exp2(-8.0 * jnp.arange(1, DIFF_HEADS + 1, dtype=jnp.float32) / DIFF_HEADS)
    dist = jnp.abs(q_pos[:, None] - k_pos[None, :]).astype(jnp.float32)
    alibi = -slopes[:, None, None] * dist[None]
    mask = (k_pos[None, :] // CHUNK) <= (q_pos[:, None] // CHUNK)

    def attn_map(qa, ka):
        s = jnp.einsum('bqhd,bshd->bhqs', qa, ka, preferred_element_type=jnp.float32) * (DIFF_HD ** -0.5)
        return jax.nn.softmax(jnp.where(mask, s + alibi, NEG_INF), axis=-1)

    a = attn_map(q1, k1) - lam * attn_map(q2, k2)
    return jnp.einsum('bhqs,bshd->bqhd', a.astype(v.dtype), v)


def _diff_mixer(x, layer_idx, w_in, lam_params, subln_g, w_out, past_k=None, past_v=None):
    b, t, _ = x.shape
    proj = x @ w_in
    q, k, v = jnp.split(proj, 3, axis=-1)
    q = q.reshape(b, t, DIFF_HEADS, 2 * DIFF_HD)
    k = k.reshape(b, t, DIFF_HEADS, 2 * DIFF_HD)
    v = v.reshape(b, t, DIFF_HEADS, 2 * DIFF_HD)
    lam_init = 0.8 - 0.6 * math.exp(-0.3 * layer_idx)
    lp = lam_params.astype(jnp.float32)
    lam = jnp.exp(jnp.sum(lp[0] * lp[1])) - jnp.exp(jnp.sum(lp[2] * lp[3])) + lam_init
    if past_k is None:
        k_all, v_all, offset = k, v, 0
    else:
        offset = past_k.shape[1]
        k_all = jnp.concatenate([past_k, k], axis=1)
        v_all = jnp.concatenate([past_v, v], axis=1)
    k_pos = jnp.arange(k_all.shape[1])
    q_pos = offset + jnp.arange(t)
    o = _sweep_queries(functools.partial(_diff_block, lam), q_pos, (q,), (k_pos, k_all, v_all))
    of = o.astype(jnp.float32)
    of = of * lax.rsqrt(jnp.mean(jnp.square(of), axis=-1, keepdims=True) + LN_EPS)
    of = of * subln_g.astype(jnp.float32) * (1.0 - lam_init)
    y = of.astype(x.dtype).reshape(b, t, D_MODEL) @ w_out
    return y, k, v


def _swiglu(x, w_in, w_out):
    g, u = jnp.split(x @ w_in, 2, axis=-1)
    return (jax.nn.silu(g) * u) @ w_out


def setup_inputs(seed: int = 0) -> dict:
    key = jax.random.key(seed)
    ks = jax.random.split(key, 20)
    f32 = jnp.float32
    s_d = D_MODEL ** -0.5
    fox_w_in = jax.random.normal(ks[7], (N_FOX, D_MODEL, 3 * D_MODEL + FOX_HEADS), f32) * s_d
    fox_w_in = fox_w_in.at[:, :, 2 * D_MODEL:3 * D_MODEL].multiply(DEEPNORM_BETA)
    diff_w_in = jax.random.normal(ks[10], (N_DIFF, D_MODEL, 3 * D_MODEL), f32) * s_d
    diff_w_in = diff_w_in.at[:, :, 2 * D_MODEL:].multiply(DEEPNORM_BETA)
    return {
        'x_prompt': jax.random.normal(ks[0], (BATCH, SEQ, D_MODEL), f32),
        'x_sample': jax.random.normal(ks[1], (DEC_BATCH, DEC_SEQ, D_MODEL), f32),
        'cache_fox_k': jax.random.normal(ks[2], (N_FOX, DEC_BATCH, PAST_LEN, FOX_HEADS, FOX_HD), f32),
        'cache_fox_v': jax.random.normal(ks[3], (N_FOX, DEC_BATCH, PAST_LEN, FOX_HEADS, FOX_HD), f32),
        'cache_fox_logf': jax.nn.log_sigmoid(3.0 + jax.random.normal(ks[4], (N_FOX, DEC_BATCH, PAST_LEN, FOX_HEADS), f32)),
        'cache_diff_k': jax.random.normal(ks[5], (N_DIFF, DEC_BATCH, PAST_LEN, DIFF_HEADS, 2 * DIFF_HD), f32),
        'cache_diff_v': jax.random.normal(ks[6], (N_DIFF, DEC_BATCH, PAST_LEN, DIFF_HEADS, 2 * DIFF_HD), f32),
        'fox_w_in': fox_w_in,
        'fox_b_f': 1.0 + 4.0 * jax.random.uniform(ks[8], (N_FOX, FOX_HEADS), f32),
        'fox_w_out': jax.random.normal(ks[9], (N_FOX, D_MODEL, D_MODEL), f32) * s_d * DEEPNORM_BETA,
        'diff_w_in': diff_w_in,
        'diff_lambda': 0.1 * jax.random.normal(ks[11], (N_DIFF, 4, DIFF_HD), f32),
        'diff_subln_g': 1.0 + 0.01 * jax.random.normal(ks[12], (N_DIFF, 2 * DIFF_HD), f32),
        'diff_w_out': jax.random.normal(ks[13], (N_DIFF, D_MODEL, D_MODEL), f32) * s_d * DEEPNORM_BETA,
        'ffn_w_in': jax.random.normal(ks[14], (DEPTH, D_MODEL, 2 * D_FF), f32) * s_d,
        'ffn_w_out': jax.random.normal(ks[15], (DEPTH, D_FF, D_MODEL), f32) * (D_FF ** -0.5) * DEEPNORM_BETA,
        'ln_g': 1.0 + 0.01 * jax.random.normal(ks[16], (DEPTH, 2, D_MODEL), f32),
        'ln_b': 0.01 * jax.random.normal(ks[17], (DEPTH, 2, D_MODEL), f32),
    }


def reference(x_prompt, x_sample, cache_fox_k, cache_fox_v, cache_fox_logf, cache_diff_k, cache_diff_v,
              fox_w_in, fox_b_f, fox_w_out, diff_w_in, diff_lambda, diff_subln_g, diff_w_out,
              ffn_w_in, ffn_w_out, ln_g, ln_b):
    def run(x, past):
        fk, fv, ff, dk, dv = [], [], [], [], []
        for i in range(DEPTH):
            j = i // N_MIXERS
            if i % N_MIXERS == 0:
                pk, pv, pf = (None, None, None) if past is None else (past[0][j], past[1][j], past[2][j])
                y, k, v, lf = _fox_mixer(x, fox_w_in[j], fox_b_f[j], fox_w_out[j], pk, pv, pf)
                fk.append(k)
                fv.append(v)
                ff.append(lf)
            else:
                pk, pv = (None, None) if past is None else (past[3][j], past[4][j])
                y, k, v = _diff_mixer(x, i, diff_w_in[j], diff_lambda[j], diff_subln_g[j], diff_w_out[j], pk, pv)
                dk.append(k)
                dv.append(v)
            x = _layernorm(DEEPNORM_ALPHA * x + y, ln_g[i, 0], ln_b[i, 0])
            x = _layernorm(DEEPNORM_ALPHA * x + _swiglu(x, ffn_w_in[i], ffn_w_out[i]), ln_g[i, 1], ln_b[i, 1])
        return x, jnp.stack(fk), jnp.stack(fv), jnp.stack(ff), jnp.stack(dk), jnp.stack(dv)

    y_prompt, fox_k_p, fox_v_p, fox_logf_p, diff_k_p, diff_v_p = run(x_prompt, None)
    past = (cache_fox_k, cache_fox_v, cache_fox_logf, cache_diff_k, cache_diff_v)
    y_sample, fox_k_s, fox_v_s, fox_logf_s, diff_k_s, diff_v_s = run(x_sample, past)
    return (y_prompt, y_sample, fox_k_p, fox_v_p, fox_logf_p, diff_k_p, diff_v_p,
            fox_k_s, fox_v_s, fox_logf_s, diff_k_s, diff_v_s)
```

```cpp
#include <hip/hip_runtime.h>
#include <cstdio>
#include <cstdint>
namespace pg8 {
#define PG8_LAS __attribute__((address_space(3)))
typedef unsigned short bf16_t;
typedef short bf16x8 __attribute__((ext_vector_type(8)));
typedef float f32x4 __attribute__((ext_vector_type(4)));
typedef unsigned u32x4 __attribute__((ext_vector_type(4)));
constexpr int BM = 256, BK = 64, HALF = 128, HTB = HALF * BK * 2  , STAGE_BYTES = 8 * HTB, NXCD = 8, WGM = 8;

__host__ __device__ __forceinline__ int lds_byte(int r, int c) { const int st = (r >> 4) * 2 + (c >> 5), rr = r & 15, cc = c & 31, ob = rr * 64 + cc * 2; return st * 1024 + (ob ^ (((ob >> 9) & 1) << 5)); }
__host__ __device__ __forceinline__ void stage_rc(int b, int& R, int& C) { const int st = b / 1024, sb = b % 1024, swz = sb ^ (((sb >> 9) & 1) << 5); R = (st >> 1) * 16 + swz / 64; C = (st & 1) * 32 + (swz % 64) / 2; }
__host__ __device__ __forceinline__ int perm32(int rho) { const int n = rho >> 4, i = rho & 15; return 8 * (i >> 2) + 4 * n + (i & 3); }

struct Unit { int pm, pn; };
struct Gemm { const bf16_t* A; const bf16_t* Bt; int M, N, K; };

struct StaticOrder {
    int nM, nN, nwg, G, c;
    __host__ __device__ void init(int M, int N, int G_, int c_) { nM = M / BM; nN = N / BM; nwg = nM * nN; G = G_; c = c_; }
    __host__ __device__ bool next(int i, Unit& u) const {
        const long L = (long)i * G + c; if (L >= nwg) return false;
        int wgid = (int)L; { const int q = nwg / NXCD, r = nwg % NXCD, xcd = wgid % NXCD, off = wgid / NXCD; wgid = (xcd < r ? xcd * (q + 1) : r * (q + 1) + (xcd - r) * q) + off; }
        const int nig = WGM * nN, gid = wgid / nig, fm = gid * WGM, gsz = (nM - fm) < WGM ? (nM - fm) : WGM;
        u.pm = fm + ((wgid % nig) % gsz); u.pn = (wgid % nig) / gsz; return true;
    }
    __device__ __forceinline__ void a_ready(const Unit&) const {}
    __device__ __forceinline__ void done(const Unit&) const {}
};

__device__ __forceinline__ unsigned cvt_pk_bf16(float lo, float hi) { unsigned r; asm volatile("v_cvt_pk_bf16_f32 %0, %1, %2" : "=v"(r) : "v"(lo), "v"(hi)); return r; }
typedef float f32x2 __attribute__((ext_vector_type(2)));
struct EpiQKV {
    static constexpr bool PERM = true, AFTER_DRAIN = false;
    bf16_t* Q; size_t qkv_stride; float* okp; float* oks; float qscale;
    __device__ __forceinline__ void operator()(const f32x4 (&acc)[2][2][4][2], const Unit& u, int wr, int wc, int fr, int fq) const {
        const int t = u.pn >> 2, colt = (u.pn & 3) * BM; const bool samp = u.pm >= 128;
        bf16_t* base = Q + (size_t)t * qkv_stride;
        float* fbase = samp ? oks + (size_t)(t == 2 ? 512 * 1024 : 0) - (size_t)32768 * 1024 : okp + (size_t)(t == 2 ? 32768 * 1024 : 0);
        const float sc = t == 0 ? qscale : 1.f;
        const int row0 = u.pm * BM + wr * 64 + fr, col0 = colt + wc * 32 + 8 * fq;
#pragma unroll
        for (int ai = 0; ai < 2; ++ai)
#pragma unroll
            for (int m = 0; m < 4; ++m) { const int row = row0 + ai * HALF + m * 16;
#pragma unroll
                for (int bj = 0; bj < 2; ++bj) { const f32x4 v0 = acc[ai][bj][m][0] * sc, v1 = acc[ai][bj][m][1] * sc;
                    u32x4 w; w.x = cvt_pk_bf16(v0[0], v0[1]); w.y = cvt_pk_bf16(v0[2], v0[3]); w.z = cvt_pk_bf16(v1[0], v1[1]); w.w = cvt_pk_bf16(v1[2], v1[3]);
                    *(u32x4*)(base + (size_t)row * 1024 + col0 + bj * HALF) = w;
                    if (t != 0) { float* fp = fbase + (size_t)row * 1024 + col0 + bj * HALF; *(f32x4*)fp = v0; *(f32x4*)(fp + 4) = v1; } } }
    }
};
struct EpiF32 {
    static constexpr bool PERM = true, AFTER_DRAIN = false;
    float* Y; int ldc;
    __device__ __forceinline__ void operator()(const f32x4 (&acc)[2][2][4][2], const Unit& u, int wr, int wc, int fr, int fq) const {
        const int row0 = u.pm * BM + wr * 64 + fr, col0 = u.pn * BM + wc * 32 + 8 * fq;
#pragma unroll
        for (int ai = 0; ai < 2; ++ai)
#pragma unroll
            for (int m = 0; m < 4; ++m) { float* rp = Y + (size_t)(row0 + ai * HALF + m * 16) * ldc + col0;
#pragma unroll
                for (int bj = 0; bj < 2; ++bj) { *(f32x4*)(rp + bj * HALF) = acc[ai][bj][m][0]; *(f32x4*)(rp + bj * HALF + 4) = acc[ai][bj][m][1]; } }
    }
};
struct EpiSwiGLU {
    static constexpr bool PERM = true, AFTER_DRAIN = false;
    bf16_t* H; int ldc;
    __device__ __forceinline__ void operator()(const f32x4 (&acc)[2][2][4][2], const Unit& u, int wr, int wc, int fr, int fq) const {
        const int row0 = u.pm * BM + wr * 64 + fr, col0 = u.pn * HALF + wc * 32 + 8 * fq;
#pragma unroll
        for (int ai = 0; ai < 2; ++ai)
#pragma unroll
            for (int m = 0; m < 4; ++m) { float r[8];
#pragma unroll
                for (int n = 0; n < 2; ++n)
#pragma unroll
                    for (int i = 0; i < 4; ++i) { const float g = acc[ai][0][m][n][i], uu = acc[ai][1][m][n][i];
                        r[4 * n + i] = g * uu * __builtin_amdgcn_rcpf(1.0f + __builtin_amdgcn_exp2f(-1.4426950408889634f * g)); }
                u32x4 w; w.x = cvt_pk_bf16(r[0], r[1]); w.y = cvt_pk_bf16(r[2], r[3]); w.z = cvt_pk_bf16(r[4], r[5]); w.w = cvt_pk_bf16(r[6], r[7]);
                *(u32x4*)(H + (size_t)(row0 + ai * HALF + m * 16) * ldc + col0) = w; }
    }
};
template <class Epi, class Sched, bool ALIGN_EPI = false, bool SP2 = false>
__device__ __forceinline__ void gemm_phase(PG8_LAS unsigned char* lds, const Gemm g, const Sched& S, const Epi& E) {
    int tid_ = threadIdx.x; asm volatile("" : "+v"(tid_));
    const int tid = tid_, wid = __builtin_amdgcn_readfirstlane(tid >> 6), lane = tid & 63, wr = wid >> 2, wc = wid & 3, fr = lane & 15, fq = lane >> 4;
    const int K = g.K, nt = K / BK;
    unsigned voffA[2], voffB[2];
#pragma unroll
    for (int i = 0; i < 2; ++i) { int R, C; stage_rc(tid * 16 + i * 8192, R, C); const int Rb = Epi::PERM ? ((R & ~31) + perm32(R & 31)) : R;
        voffA[i] = (unsigned)(R * K + C) * 2u; voffB[i] = (unsigned)(Rb * K + C) * 2u; }
    const size_t kstep = (size_t)(BK * 2);
    const size_t hstep = (size_t)HALF * K * 2;
    const size_t tstep = 2 * hstep;
    const unsigned ldsw = (unsigned)wid * 1024u;
    const int aoff = lds_byte(wr * 64 + fr, fq * 8), boff = lds_byte(wc * 32 + fr, fq * 8);
#define PG8_SA(b, h) (((b) * 2 + (h)) * HTB)
#define PG8_SB(b, h) ((4 + (b) * 2 + (h)) * HTB)
#define PG8_STAGE(bufoff, gbase, voff) do { _Pragma("unroll") for (int _i = 0; _i < 2; ++_i) \
        __builtin_amdgcn_global_load_lds((const unsigned*)((const char*)(gbase) + (voff)[_i]), (PG8_LAS unsigned*)(lds + (bufoff) + ldsw + _i * 8192), 16, 0, 0); } while (0)
#define PG8_LDA(dst, b, h) do { _Pragma("unroll") for (int m = 0; m < 4; ++m) _Pragma("unroll") for (int k = 0; k < 2; ++k) dst[m][k] = *(const PG8_LAS bf16x8*)(lds + PG8_SA(b, h) + aoff + m * 2048 + k * 1024); } while (0)
#define PG8_LDB(dst, b, h) do { _Pragma("unroll") for (int n = 0; n < 2; ++n) _Pragma("unroll") for (int k = 0; k < 2; ++k) dst[n][k] = *(const PG8_LAS bf16x8*)(lds + PG8_SB(b, h) + boff + n * 2048 + k * 1024); } while (0)
#define PG8_MMA(ai, bj, At, Bt) do { __builtin_amdgcn_s_setprio(1); _Pragma("unroll") for (int m = 0; m < 4; ++m) _Pragma("unroll") for (int n = 0; n < 2; ++n) _Pragma("unroll") for (int k = 0; k < 2; ++k) \
        acc[ai][bj][m][n] = __builtin_amdgcn_mfma_f32_16x16x32_bf16(Bt[n][k], At[m][k], acc[ai][bj][m][n], 0, 0, 0); __builtin_amdgcn_s_setprio(0); } while (0)
#define PG8_WAIT_V(n) asm volatile("s_waitcnt vmcnt(" #n ")" ::: "memory")
#define PG8_WAIT_L(n) asm volatile("s_waitcnt lgkmcnt(" #n ")" ::: "memory")
#define PG8_BAR __builtin_amdgcn_s_barrier()
#define PG8_SCHED __builtin_amdgcn_sched_barrier(0)
    Unit cur, nxt; int ui = 0;
    if (!S.next(0, cur)) return;
    f32x4 acc[2][2][4][2];
#pragma unroll
    for (int a = 0; a < 2; ++a)
#pragma unroll
        for (int b = 0; b < 2; ++b)
#pragma unroll
            for (int m = 0; m < 4; ++m)
#pragma unroll
                for (int n = 0; n < 2; ++n) acc[a][b][m][n] = (f32x4){0.f, 0.f, 0.f, 0.f};
    bf16x8 At[4][2], B0[2][2], B1[2][2];
    const char* cA = (const char*)g.A + (size_t)cur.pm * tstep; const char* cB = (const char*)g.Bt + (size_t)cur.pn * tstep;
    S.a_ready(cur);
    if constexpr (SP2) {
        PG8_STAGE(PG8_SB(0, 0), cB, voffB); PG8_STAGE(PG8_SB(0, 1), cB + hstep, voffB); PG8_STAGE(PG8_SA(0, 0), cA, voffA); PG8_STAGE(PG8_SA(0, 1), cA + hstep, voffA);
        if (wr == 1) PG8_BAR;
        PG8_WAIT_V(2); PG8_BAR;
        PG8_STAGE(PG8_SB(1, 0), cB + kstep, voffB); PG8_STAGE(PG8_SA(1, 0), cA + kstep, voffA); PG8_STAGE(PG8_SB(1, 1), cB + hstep + kstep, voffB);
        PG8_WAIT_V(6); PG8_BAR;
    } else {
        PG8_STAGE(PG8_SB(0, 0), cB, voffB); PG8_STAGE(PG8_SA(0, 0), cA, voffA); PG8_STAGE(PG8_SB(0, 1), cB + hstep, voffB); PG8_STAGE(PG8_SA(0, 1), cA + hstep, voffA);
        if (wr == 1) PG8_BAR;
        PG8_WAIT_V(4); PG8_BAR;
        PG8_STAGE(PG8_SB(1, 0), cB + kstep, voffB); PG8_STAGE(PG8_SA(1, 0), cA + kstep, voffA); PG8_STAGE(PG8_SB(1, 1), cB + hstep + kstep, voffB);
        PG8_WAIT_V(6); PG8_BAR;
    }
    for (;;) {
        const bool has_next = S.next(ui + 1, nxt);
        const char* nA = has_next ? (const char*)g.A + (size_t)nxt.pm * tstep : cA; const char* nB = has_next ? (const char*)g.Bt + (size_t)nxt.pn * tstep : cB;
        for (int t = 0; t < nt; t += 2) {
            const bool last = (t == nt - 2);
            const char* a1 = cA + (size_t)(t + 1) * kstep;
            const char* a2 = last ? nA : cA + (size_t)(t + 2) * kstep; const char* b2 = last ? nB : cB + (size_t)(t + 2) * kstep;
            const char* a3 = a2 + kstep; const char* b3 = b2 + kstep;
            if (last && has_next) S.a_ready(nxt);
            if constexpr (SP2) {
            PG8_LDB(B0, 0, 0); PG8_LDB(B1, 0, 1); PG8_SCHED; PG8_LDA(At, 0, 0); PG8_STAGE(PG8_SA(1, 1), a1 + hstep, voffA);
            PG8_WAIT_V(8); PG8_WAIT_L(0); PG8_BAR; PG8_MMA(0, 0, At, B0); PG8_MMA(0, 1, At, B1); PG8_BAR; PG8_SCHED;
            PG8_LDA(At, 0, 1); PG8_STAGE(PG8_SB(0, 0), b2, voffB); PG8_STAGE(PG8_SB(0, 1), b2 + hstep, voffB); PG8_STAGE(PG8_SA(0, 0), a2, voffA);
            PG8_WAIT_V(8); PG8_WAIT_L(0); PG8_BAR; PG8_MMA(1, 0, At, B0); PG8_MMA(1, 1, At, B1); PG8_BAR; PG8_SCHED;
            PG8_LDB(B0, 1, 0); PG8_LDB(B1, 1, 1); PG8_SCHED; PG8_LDA(At, 1, 0); PG8_STAGE(PG8_SA(0, 1), a2 + hstep, voffA);
            PG8_WAIT_V(8); PG8_WAIT_L(0); PG8_BAR; PG8_MMA(0, 0, At, B0); PG8_MMA(0, 1, At, B1); PG8_BAR; PG8_SCHED;
            PG8_LDA(At, 1, 1); PG8_STAGE(PG8_SB(1, 0), b3, voffB); PG8_STAGE(PG8_SB(1, 1), b3 + hstep, voffB); PG8_STAGE(PG8_SA(1, 0), a3, voffA);
            PG8_WAIT_V(8); PG8_WAIT_L(0); PG8_BAR; PG8_MMA(1, 0, At, B0); PG8_MMA(1, 1, At, B1); PG8_BAR; PG8_SCHED;
            } else {
            PG8_LDB(B0, 0, 0); PG8_SCHED; PG8_LDA(At, 0, 0); PG8_STAGE(PG8_SA(1, 1), a1 + hstep, voffA);
            PG8_WAIT_L(8); PG8_BAR; PG8_WAIT_L(0); PG8_MMA(0, 0, At, B0); PG8_BAR; PG8_SCHED;
            PG8_LDB(B1, 0, 1); PG8_STAGE(PG8_SB(0, 0), b2, voffB);
            PG8_BAR; PG8_WAIT_L(0); PG8_MMA(0, 1, At, B1); PG8_BAR;
            PG8_LDA(At, 0, 1); PG8_STAGE(PG8_SA(0, 0), a2, voffA);
            PG8_BAR; PG8_WAIT_L(0); PG8_MMA(1, 0, At, B0); PG8_BAR; PG8_SCHED;
            PG8_STAGE(PG8_SB(0, 1), b2 + hstep, voffB);
            PG8_WAIT_V(6); PG8_BAR; PG8_MMA(1, 1, At, B1); PG8_BAR;
            PG8_LDB(B0, 1, 0); PG8_SCHED; PG8_LDA(At, 1, 0); PG8_STAGE(PG8_SA(0, 1), a2 + hstep, voffA);
            PG8_WAIT_L(8); PG8_BAR; PG8_WAIT_L(0); PG8_MMA(0, 0, At, B0); PG8_BAR; PG8_SCHED;
            PG8_LDB(B1, 1, 1); PG8_STAGE(PG8_SB(1, 0), b3, voffB);
            PG8_BAR; PG8_WAIT_L(0); PG8_MMA(0, 1, At, B1); PG8_BAR;
            PG8_LDA(At, 1, 1); PG8_STAGE(PG8_SA(1, 0), a3, voffA);
            PG8_BAR; PG8_WAIT_L(0); PG8_MMA(1, 0, At, B0); PG8_BAR; PG8_SCHED;
            PG8_STAGE(PG8_SB(1, 1), b3 + hstep, voffB);
            PG8_WAIT_V(6); PG8_BAR; PG8_MMA(1, 1, At, B1); PG8_BAR;
            }
        }
        if constexpr (ALIGN_EPI) { if (wr == 0) PG8_BAR; }
        if constexpr (!Epi::AFTER_DRAIN) { E(acc, cur, wr, wc, fr, fq); S.done(cur); }
        if (!has_next) break;
#pragma unroll
        for (int a = 0; a < 2; ++a)
#pragma unroll
            for (int b = 0; b < 2; ++b)
#pragma unroll
                for (int m = 0; m < 4; ++m)
#pragma unroll
                    for (int n = 0; n < 2; ++n) acc[a][b][m][n] = (f32x4){0.f, 0.f, 0.f, 0.f};
        cur = nxt; cA = nA; cB = nB; ++ui;
        if constexpr (ALIGN_EPI) { if (wr == 1) PG8_BAR; }
    }
    PG8_WAIT_V(0);
    if constexpr (!ALIGN_EPI) { if (wr == 0) PG8_BAR; }
    PG8_BAR;
    if constexpr (Epi::AFTER_DRAIN) { E.fused(acc, cur, wr, wc, fr, fq, lds, wid, lane); S.done(cur); }
#undef PG8_SA
#undef PG8_SB
#undef PG8_STAGE
#undef PG8_LDA
#undef PG8_LDB
#undef PG8_MMA
#undef PG8_WAIT_V
#undef PG8_WAIT_L
#undef PG8_BAR
#undef PG8_SCHED
}
}

#ifndef PG8_SP2
#define PG8_SP2 true
#endif
#ifndef PG8_ALIGN
#define PG8_ALIGN true
#endif
#include <hip/hip_bf16.h>
#include <cmath>
namespace attn_body {
using bf16=__hip_bfloat16;
using bf16x8=__attribute__((ext_vector_type(8)))short;
using s16x4=__attribute__((ext_vector_type(4)))short;
using f32x16=__attribute__((ext_vector_type(16)))float;
using u32x4=__attribute__((ext_vector_type(4)))unsigned;
constexpr int BATCH=2,NHEAD=16,SEQ=16384,D=64,DM=NHEAD*D;
constexpr int NW=8,QBLK=32,QB=QBLK*NW,KVBLK=64,NQB=SEQ/QB;
constexpr int ATTN_PITCH=DM, ATTN_UNIT_ROWS=QB;
__device__ __forceinline__ int crow(int r,int hi){return (r&3)+8*(r>>2)+4*hi;}
#define SBAR() __builtin_amdgcn_sched_barrier(0)
__device__ __forceinline__ void cmask(f32x16&p0,f32x16&p1,int jb,int qrel,int hi){
  const float NEG=-INFINITY; int kb=64*jb+4*hi;
  #pragma unroll
  for(int r=0;r<16;++r){int kv=kb+(r&3)+8*(r>>2); if(kv>qrel)p0[r]=NEG; if(kv+32>qrel)p1[r]=NEG;}
}

__device__ __forceinline__ void dmask(f32x16&p0,f32x16&p1,int jb,int qrel,int hi,float s2){
  const float NEG=-INFINITY; const int c=qrel>>6; const int kb=64*jb+4*hi;
  if(jb>c){
    #pragma unroll
    for(int r=0;r<16;++r){p0[r]=NEG;p1[r]=NEG;}
  } else if(jb==c){
    #pragma unroll
    for(int r=0;r<16;++r){const int kv=kb+(r&3)+8*(r>>2); if(kv>qrel)p0[r]+=s2*(float)(qrel-kv); if(kv+32>qrel)p1[r]+=s2*(float)(qrel-kv-32);}
  }
}
typedef float f32x4_t __attribute__((ext_vector_type(4)));
constexpr int NSLOT=3, SLOTB=8192;
constexpr int LDS_K=0, LDS_V=NSLOT*SLOTB, LDS_WS=2*NSLOT*SLOTB, LDS_OST=LDS_WS+NW*64*4, LDS_TAB=LDS_OST+NW*4096, LDS_BYTES=LDS_TAB+SEQ*4;
constexpr float C2=0.125f*1.4426950408889634f;
__device__ __forceinline__ void glds16(const void*gsrc,unsigned lds_dst){unsigned keep;
  asm volatile("s_mov_b32 %0, m0\n\ts_mov_b32 m0, %2\n\ts_nop 0\n\tglobal_load_lds_dwordx4 %1, off\n\ts_mov_b32 m0, %0":"=&s"(keep):"v"(gsrc),"s"(lds_dst):"memory");}
__device__ __forceinline__ float max3f(float a,float b,float c){float r;asm("v_max3_f32 %0, %1, %2, %3":"=v"(r):"v"(a),"v"(b),"v"(c));return r;}
__device__ __forceinline__ float max2f(float a,float b){float r;asm("v_max_f32_e32 %0, %1, %2":"=v"(r):"v"(a),"v"(b));return r;}
__device__ __forceinline__ float fadd_s(float a,float b){float r;asm("v_add_f32_e32 %0, %1, %2":"=v"(r):"v"(a),"v"(b));return r;}
__device__ __forceinline__ float fsub_s(float a,float b){float r;asm("v_sub_f32_e32 %0, %1, %2":"=v"(r):"v"(a),"v"(b));return r;}
typedef float f32x2_t __attribute__((ext_vector_type(2))); typedef __bf16 bf16x2_t __attribute__((ext_vector_type(2)));
__device__ __forceinline__ unsigned cvtpk_s(float lo,float hi){f32x2_t v={lo,hi};bf16x2_t b=__builtin_convertvector(v,bf16x2_t);return __builtin_bit_cast(unsigned,b);}
#define WAIT_BAR(N) asm volatile("s_waitcnt vmcnt(" #N ") lgkmcnt(0)\n\ts_barrier":::"memory")

__device__ __forceinline__ void qkt(f32x16&p0,f32x16&p1,const char*Kslot,const bf16x8*qr,int r32,int hi){
  const char*kb=Kslot+hi*1024+r32*16;
  #pragma unroll
  for(int d0=0;d0<4;++d0){
    const bf16x8 b0=*reinterpret_cast<const bf16x8*>(kb+d0*2048);
    const bf16x8 b1=*reinterpret_cast<const bf16x8*>(kb+d0*2048+512);
    {p0=__builtin_amdgcn_mfma_f32_32x32x16_bf16(b0,qr[d0],p0,0,0,0);p1=__builtin_amdgcn_mfma_f32_32x32x16_bf16(b1,qr[d0],p1,0,0,0);}}
}
typedef __attribute__((address_space(3))) const char* lds_cptr;
typedef short v4i16_t __attribute__((ext_vector_type(4)));
__device__ __forceinline__ void kload8(bf16x8*kf,lds_cptr kp){
  kf[0]=*(const __attribute__((address_space(3))) bf16x8*)(kp);      kf[1]=*(const __attribute__((address_space(3))) bf16x8*)(kp+512);
  kf[2]=*(const __attribute__((address_space(3))) bf16x8*)(kp+2048); kf[3]=*(const __attribute__((address_space(3))) bf16x8*)(kp+2560);
  kf[4]=*(const __attribute__((address_space(3))) bf16x8*)(kp+4096); kf[5]=*(const __attribute__((address_space(3))) bf16x8*)(kp+4608);
  kf[6]=*(const __attribute__((address_space(3))) bf16x8*)(kp+6144); kf[7]=*(const __attribute__((address_space(3))) bf16x8*)(kp+6656);
}
__device__ __forceinline__ void kload2(bf16x8*kf,lds_cptr kp,int j){ kf[2*j]=*(const __attribute__((address_space(3))) bf16x8*)(kp+j*2048); kf[2*j+1]=*(const __attribute__((address_space(3))) bf16x8*)(kp+j*2048+512); }
__device__ __forceinline__ s16x4 vtr(lds_cptr p){ return __builtin_bit_cast(s16x4,__builtin_amdgcn_ds_read_tr16_b64_v4i16((__attribute__((address_space(3))) v4i16_t*)p)); }
__device__ __forceinline__ float rowmax(const f32x16&p0,const f32x16&p1){
  float a=max3f(p0[0],p0[1],p1[0]),b=max3f(p0[2],p0[3],p1[1]);a=max3f(a,p1[2],p1[3]);
  #pragma unroll
  for(int r=4;r<16;r+=4){a=max3f(a,p0[r],p0[r+1]);b=max3f(b,p0[r+2],p0[r+3]);a=max3f(a,p1[r],p1[r+1]);b=max3f(b,p1[r+2],p1[r+3]);}
  const float m=max2f(a,b);
  auto rr=__builtin_amdgcn_permlane32_swap(__float_as_uint(m),__float_as_uint(m),false,false);
  return max2f(__uint_as_float(rr[0]),__uint_as_float(rr[1]));
}
__device__ __forceinline__ void pv(f32x16*o,int vb,bf16x8 pa0,bf16x8 pa1,bf16x8 pa2,bf16x8 pa3){
  #pragma unroll
  for(int d0=0;d0<2;++d0){s16x4 lo[4],hi[4];
    #pragma unroll
    for(int ks=0;ks<4;++ks){
      asm volatile("ds_read_b64_tr_b16 %0,%1 offset:%c2":"=&v"(lo[ks]):"v"(vb),"i"(d0*4096+ks*1024):"memory");
      asm volatile("ds_read_b64_tr_b16 %0,%1 offset:%c2":"=&v"(hi[ks]):"v"(vb),"i"(d0*4096+ks*1024+512):"memory");}
    asm volatile("s_waitcnt lgkmcnt(0)":::"memory");SBAR();
    #define PK(k) (bf16x8){lo[k][0],lo[k][1],lo[k][2],lo[k][3],hi[k][0],hi[k][1],hi[k][2],hi[k][3]}
    o[d0]=__builtin_amdgcn_mfma_f32_32x32x16_bf16(pa0,PK(0),o[d0],0,0,0);
    o[d0]=__builtin_amdgcn_mfma_f32_32x32x16_bf16(pa1,PK(1),o[d0],0,0,0);
    o[d0]=__builtin_amdgcn_mfma_f32_32x32x16_bf16(pa2,PK(2),o[d0],0,0,0);
    o[d0]=__builtin_amdgcn_mfma_f32_32x32x16_bf16(pa3,PK(3),o[d0],0,0,0);
    #undef PK
  }
}

#ifndef ATTN_STORE16
#define ATTN_STORE16(p,v) (*(u32x4*)(p)=(v))
#endif
template<int MODE,int THRL> __device__ __forceinline__ void attn_unit(long rowbase,int qb,int t0,const bf16*Q,const bf16*__restrict__ K,const bf16*__restrict__ V,bf16*O,char*shm,float s2){
  int tid_=threadIdx.x; asm volatile("":"+v"(tid_)); const int tid=tid_,lane=tid&63,r32=lane&31,hi=lane>>5; const int wid=__builtin_amdgcn_readfirstlane(tid>>6);
  const int q0=qb*QB;
  const bf16*Qw=Q+(rowbase+q0+wid*QBLK)*DM;
  const bf16*Kh=K+(rowbase+(long)t0*KVBLK)*DM,*Vh=V+(rowbase+(long)t0*KVBLK)*DM;
  const unsigned lds0=(unsigned)(uintptr_t)shm;
  float*wsf=(float*)(shm+LDS_WS)+wid*64;
  const bf16*ksrc=Kh+(long)lane*DM+wid*8;
  const bf16*vsrc=Vh+(long)(16*(wid&3)+(lane>>2))*DM+(wid>>2)*32+(lane&3)*8;
  const unsigned kdst=lds0+LDS_K+wid*1024, vdst=lds0+LDS_V+wid*1024;
  #define DMA_K(t,slot) glds16(ksrc+(long)(t)*KVBLK*DM,(unsigned)__builtin_amdgcn_readfirstlane(kdst+(slot)))
  #define DMA_V(t,slot) glds16(vsrc+(long)(t)*KVBLK*DM,(unsigned)__builtin_amdgcn_readfirstlane(vdst+(slot)))
  const int vb0=(int)(lds0+LDS_V)+((lane>>4)&1)*32+(lane&3)*8+(4*hi+((lane&15)>>2))*64;
  const char*Kbase=shm+LDS_K; bf16x8 kf[8];
  const lds_cptr shm3=(lds_cptr)shm; const lds_cptr kp0=shm3+LDS_K+hi*1024+r32*16; const lds_cptr vp0=shm3+LDS_V+((lane>>4)&1)*32+(lane&3)*8+(4*hi+((lane&15)>>2))*64;
  const int NT=(q0+QB)/KVBLK-t0;
  DMA_K(0,0);DMA_V(0,0);DMA_K(1,SLOTB);
  bf16x8 qr[4];
  #pragma unroll
  for(int d0=0;d0<4;++d0)qr[d0]=*reinterpret_cast<const bf16x8*>(&Qw[(long)r32*DM+d0*16+hi*8]);
  float mhat=0.f,l_reg=0.f;f32x16 o[2];o[0]=f32x16{};o[1]=f32x16{};
  const lds_cptr tb3=(lds_cptr)shm+LDS_TAB+t0*256+hi*16;
  #define BINIT(C0,C1,t) do{ const __attribute__((address_space(3))) f32x4_t* bp_=(const __attribute__((address_space(3))) f32x4_t*)(tb3+(t)*256); \
    _Pragma("unroll") for(int g_=0;g_<4;++g_){ const f32x4_t x0_=bp_[2*g_], x1_=bp_[8+2*g_]; \
      C0[4*g_]=x0_[0]-mhat;C0[4*g_+1]=x0_[1]-mhat;C0[4*g_+2]=x0_[2]-mhat;C0[4*g_+3]=x0_[3]-mhat; \
      C1[4*g_]=x1_[0]-mhat;C1[4*g_+1]=x1_[1]-mhat;C1[4*g_+2]=x1_[2]-mhat;C1[4*g_+3]=x1_[3]-mhat; } }while(0)
  const int qrel=wid*QBLK+r32;
  #define CMASK(P0,P1,t) do{int jb_=(t)-(NT-4); if(jb_>=0){ if(MODE==0)cmask(P0,P1,jb_,qrel,hi); else dmask(P0,P1,jb_,qrel,hi,s2);} }while(0)
  bool resc=false;
  #define START(P0,P1) do{ const float rm=rowmax(P0,P1); resc=false; \
    { const float dl=rm; mhat=fadd_s(mhat,dl); \
      _Pragma("unroll") for(int r=0;r<16;++r){P0[r]=fsub_s(P0[r],dl);P1[r]=fsub_s(P1[r],dl);} } \
    _Pragma("unroll") for(int r=0;r<16;++r)P0[r]=__builtin_amdgcn_exp2f(P0[r]); }while(0)
  #define RESC() do{ if(resc){ asm volatile("s_waitcnt lgkmcnt(0)":::"memory"); \
      _Pragma("unroll") for(int d_=0;d_<2;++d_) _Pragma("unroll") for(int r=0;r<16;++r)o[d_][r]*=wsf[crow(r,hi)]; } }while(0)
  f32x16 pA0,pA1,pB0,pB1;
  int sl_prev=0,sl_cur=0,sl_next=SLOTB;
  #define ROT() do{sl_prev=sl_cur;sl_cur=sl_next;sl_next=(sl_next==(NSLOT-1)*SLOTB)?0:sl_next+SLOTB;}while(0)
  DMA_K(2,2*SLOTB);
  WAIT_BAR(3);
  BINIT(pA0,pA1,0); qkt(pA0,pA1,Kbase,qr,r32,hi);asm volatile("s_nop 15\n\ts_nop 7":"+v"(pA0),"+v"(pA1));CMASK(pA0,pA1,0);
  START(pA0,pA1);
  _Pragma("unroll") for(int r=0;r<16;++r)pA1[r]=__builtin_amdgcn_exp2f(pA1[r]);
  WAIT_BAR(0);
  DMA_K(3,0);DMA_V(1,SLOTB);
  ROT();
  kload8(kf,kp0+sl_cur);
  WAIT_BAR(2);
  s16x4 vlo[8],vhi[8]; u32x4 pw0,pw1,pw2,pw3;
  #define PKW(P,B) cvtpk_s(P[B],P[B+1])
  #define PAF(k) __builtin_bit_cast(bf16x8,pw##k)
  #define VFR(i) (bf16x8){vlo[i][0],vlo[i][1],vlo[i][2],vlo[i][3],vhi[i][0],vhi[i][1],vhi[i][2],vhi[i][3]}
  #define PIN(x) asm volatile("":"+v"(x))
  #define MX3(a,b,c) __builtin_fmaxf(__builtin_fmaxf((a),(b)),(c))
  #define GAPA(MF,A0,A1,A2,A3,W0,W1,PW) do{ MF; sacc+=A0; sacc+=A1; sacc+=A2; sacc+=A3; PIN(sacc); W0; W1; PIN(PW); SBAR(); }while(0)
  #define EX(v) __builtin_amdgcn_exp2f(v)
  #define GAPB(MF,X,B) do{ MF; X[B]=EX(X[B]); X[B+1]=EX(X[B+1]); X[B+2]=EX(X[B+2]); X[B+3]=EX(X[B+3]); PIN(X); SBAR(); }while(0)
  #define VRD(i) do{ vlo[i]=vtr(vp_+(((i)>>2)*4096+((i)&3)*1024)); vhi[i]=vtr(vp_+(((i)>>2)*4096+((i)&3)*1024+512)); }while(0)
  #define KRD(G,j) do{ if(G){ kload2(kf,kp0+sl_next,j); SBAR(); } }while(0)
  #define STEP(C0,C1,P0,P1,t,GK,GV,GL) do{ SBAR(); BINIT(C0,C1,t); SBAR(); \
    const lds_cptr vp_=vp0+sl_prev; \
    VRD(0); SBAR(); float sacc=(P0[0]+P0[1]); \
    GAPA(C0=__builtin_amdgcn_mfma_f32_32x32x16_bf16(kf[0],qr[0],C0,0,0,0), P0[2],P0[3],P0[4],P0[5],     pw0[0]=PKW(P0,0), pw0[1]=PKW(P0,2), pw0); \
    VRD(4); SBAR(); GAPA(C1=__builtin_amdgcn_mfma_f32_32x32x16_bf16(kf[1],qr[0],C1,0,0,0), P0[6],P0[7],P0[8],P0[9],     pw0[2]=PKW(P0,4), pw0[3]=PKW(P0,6), pw0); \
    VRD(1); SBAR(); GAPA(C0=__builtin_amdgcn_mfma_f32_32x32x16_bf16(kf[2],qr[1],C0,0,0,0),   P0[10],P0[11],P0[12],P0[13], pw1[0]=PKW(P0,8), pw1[1]=PKW(P0,10), pw1); \
    VRD(5); SBAR(); GAPA(C1=__builtin_amdgcn_mfma_f32_32x32x16_bf16(kf[3],qr[1],C1,0,0,0),   P0[14],P0[15],P1[0],P1[1],   pw1[2]=PKW(P0,12),pw1[3]=PKW(P0,14), pw1); \
    VRD(2); SBAR(); GAPA(C0=__builtin_amdgcn_mfma_f32_32x32x16_bf16(kf[4],qr[2],C0,0,0,0),   P1[2],P1[3],P1[4],P1[5],     pw2[0]=PKW(P1,0), pw2[1]=PKW(P1,2), pw2); \
    VRD(6); SBAR(); GAPA(C1=__builtin_amdgcn_mfma_f32_32x32x16_bf16(kf[5],qr[2],C1,0,0,0),   P1[6],P1[7],P1[8],P1[9],     pw2[2]=PKW(P1,4), pw2[3]=PKW(P1,6), pw2); \
    VRD(3); SBAR(); GAPA(C0=__builtin_amdgcn_mfma_f32_32x32x16_bf16(kf[6],qr[3],C0,0,0,0),   P1[10],P1[11],P1[12],P1[13], pw3[0]=PKW(P1,8), pw3[1]=PKW(P1,10), pw3); \
    VRD(7); SBAR(); GAPA(C1=__builtin_amdgcn_mfma_f32_32x32x16_bf16(kf[7],qr[3],C1,0,0,0),   P1[14],P1[15],0.f,0.f,       pw3[2]=PKW(P1,12),pw3[3]=PKW(P1,14), pw3); \
    l_reg+=sacc; \
    if(GK){DMA_K((t)+3,sl_cur);} if(GV){DMA_V((t)+1,sl_next);} \
    CMASK(C0,C1,t); \
    { float a=MX3(C0[0],C0[1],C1[0]),b=MX3(C0[2],C0[3],C1[1]); a=MX3(a,C1[2],C1[3]); \
      _Pragma("unroll") for(int r=4;r<16;r+=4){a=MX3(a,C0[r],C0[r+1]);b=MX3(b,C0[r+2],C0[r+3]);a=MX3(a,C1[r],C1[r+1]);b=MX3(b,C1[r+2],C1[r+3]);} \
      float rm=__builtin_fmaxf(a,b); { auto rr=__builtin_amdgcn_permlane32_swap(__float_as_uint(rm),__float_as_uint(rm),false,false); rm=__builtin_fmaxf(__uint_as_float(rr[0]),__uint_as_float(rr[1])); } \
      resc=false; \
      if(__builtin_expect(__any(rm>(float)THRL),0)){ const float dl=__builtin_fmaxf(rm,0.f); mhat+=dl; \
        _Pragma("unroll") for(int r=0;r<16;++r){C0[r]-=dl;C1[r]-=dl;} \
        const float f=__builtin_amdgcn_exp2f(-dl); l_reg*=f; if(hi==0)wsf[r32]=f; resc=true; } } \
    SBAR(); \
    GAPB(o[0]=__builtin_amdgcn_mfma_f32_32x32x16_bf16(PAF(0),VFR(0),o[0],0,0,0), C0,0); \
    GAPB(o[1]=__builtin_amdgcn_mfma_f32_32x32x16_bf16(PAF(0),VFR(4),o[1],0,0,0), C0,4); \
    KRD(GL,0); GAPB(o[0]=__builtin_amdgcn_mfma_f32_32x32x16_bf16(PAF(1),VFR(1),o[0],0,0,0), C0,8); \
    KRD(GL,1); GAPB(o[1]=__builtin_amdgcn_mfma_f32_32x32x16_bf16(PAF(1),VFR(5),o[1],0,0,0), C0,12); \
    KRD(GL,2); GAPB(o[0]=__builtin_amdgcn_mfma_f32_32x32x16_bf16(PAF(2),VFR(2),o[0],0,0,0), C1,0); \
    KRD(GL,3); GAPB(o[1]=__builtin_amdgcn_mfma_f32_32x32x16_bf16(PAF(2),VFR(6),o[1],0,0,0), C1,4); \
    GAPB(o[0]=__builtin_amdgcn_mfma_f32_32x32x16_bf16(PAF(3),VFR(3),o[0],0,0,0), C1,8); \
    GAPB(o[1]=__builtin_amdgcn_mfma_f32_32x32x16_bf16(PAF(3),VFR(7),o[1],0,0,0), C1,12); \
    }while(0)
  int t=1;
  #undef CMASK
  #define CMASK(P0,P1,t) do{}while(0)
  for(;t+5<NT;t+=2){
    STEP(pB0,pB1,pA0,pA1,t,true,true,true);     WAIT_BAR(2); RESC(); ROT();
    STEP(pA0,pA1,pB0,pB1,t+1,true,true,true);   WAIT_BAR(2); RESC(); ROT();
  }
  #undef CMASK
  #define CMASK(P0,P1,t) do{int jb_=(t)-(NT-4); if(jb_>=0){ if(MODE==0)cmask(P0,P1,jb_,qrel,hi); else dmask(P0,P1,jb_,qrel,hi,s2);} }while(0)
  #define ENDW(tt) do{ if((tt)+3<NT){WAIT_BAR(2);} else if((tt)+2<NT){WAIT_BAR(1);} else {WAIT_BAR(0);} }while(0)
  for(;t+1<NT;t+=2){
    STEP(pB0,pB1,pA0,pA1,t,(t+3<NT),(t+1<NT),(t+1<NT));       ENDW(t);   RESC(); ROT();
    STEP(pA0,pA1,pB0,pB1,t+1,(t+4<NT),(t+2<NT),(t+2<NT));     ENDW(t+1); RESC(); ROT();
  }
  STEP(pB0,pB1,pA0,pA1,NT-1,false,false,false); RESC();
  { float sacc=pB0[0]+pB0[1]; _Pragma("unroll") for(int r=2;r<16;++r)sacc+=pB0[r]; _Pragma("unroll") for(int r=0;r<16;++r)sacc+=pB1[r]; l_reg+=sacc;
    pw0=(u32x4){PKW(pB0,0),PKW(pB0,2),PKW(pB0,4),PKW(pB0,6)};pw1=(u32x4){PKW(pB0,8),PKW(pB0,10),PKW(pB0,12),PKW(pB0,14)};pw2=(u32x4){PKW(pB1,0),PKW(pB1,2),PKW(pB1,4),PKW(pB1,6)};pw3=(u32x4){PKW(pB1,8),PKW(pB1,10),PKW(pB1,12),PKW(pB1,14)};
    SBAR(); pv(o,vb0+sl_cur,PAF(0),PAF(1),PAF(2),PAF(3)); }
  #undef PKW
  #undef PAF
  #undef VFR
  #undef PIN
  #undef MX3
  #undef GAPA
  #undef GAPB
  #undef EX
  #undef VRD
  #undef KRD
  #undef STEP
  #undef ENDW
  {auto rr=__builtin_amdgcn_permlane32_swap(__float_as_uint(l_reg),__float_as_uint(l_reg),false,false);l_reg=__uint_as_float(rr[0])+__uint_as_float(rr[1]);}
  if(hi==0)wsf[32+r32]=l_reg;asm volatile("s_waitcnt lgkmcnt(0)":::"memory");
  float rli[16];
  #pragma unroll
  for(int r=0;r<16;++r)rli[r]=__builtin_amdgcn_rcpf(wsf[32+crow(r,hi)]);
  bf16*Ow=O+(rowbase+q0+wid*QBLK)*DM;
  { bf16*stg=(bf16*)(shm+LDS_OST)+wid*2048;
    #pragma unroll
    for(int r=0;r<16;++r){const int orow=crow(r,hi);
      #pragma unroll
      for(int d0=0;d0<2;++d0)stg[orow*64+d0*32+r32]=__float2bfloat16(o[d0][r]*rli[r]);}
    asm volatile("s_waitcnt lgkmcnt(0)":::"memory");
    #pragma unroll
    for(int i=0;i<4;++i){const int row=i*8+(lane>>3),ch=lane&7; const u32x4 v=*(const u32x4*)(stg+row*64+ch*8); ATTN_STORE16(Ow+(long)row*DM+ch*8,v);} }
  asm volatile("s_waitcnt lgkmcnt(0)\n\ts_barrier":::"memory");
  #undef DMA_K
  #undef DMA_V
  #undef CMASK
  #undef START
  #undef RESC
  #undef BINIT
  #undef ROT
}
constexpr int ATTN_LDS_BYTES=LDS_BYTES;
#undef SBAR
#undef WAIT_BAR
}
#define GAS __attribute__((address_space(1)))
#define LAS __attribute__((address_space(3)))
typedef unsigned short bf16;
typedef unsigned v4u __attribute__((ext_vector_type(4)));
typedef float f32x4 __attribute__((ext_vector_type(4)));
typedef short bf16x8 __attribute__((ext_vector_type(8)));
typedef GAS unsigned gu32;
typedef GAS unsigned long long gu64;
#define RLX_AGENT __ATOMIC_RELAXED, __HIP_MEMORY_SCOPE_AGENT
#define LDS_WAIT() asm volatile("s_waitcnt lgkmcnt(0)" ::: "memory")
#define VM_WAIT() asm volatile("s_waitcnt vmcnt(0)" ::: "memory")
__device__ __forceinline__ unsigned long long rt() { return __builtin_amdgcn_s_memrealtime(); }
__device__ __forceinline__ unsigned f2bf(float f) { unsigned u = __builtin_bit_cast(unsigned, f); return (u + 0x7fffu + ((u >> 16) & 1u)) >> 16; }
__device__ __forceinline__ unsigned pk2(float lo, float hi) { return f2bf(lo) | (f2bf(hi) << 16); }

#define XB_TMO      128
#define XB_XCNT(j)  (256  + 64 * (j))
#define XB_XSUB(j)  (1280 + 64 * (j))
#define XB_XGEN(j)  (2304 + 64 * (j))
#define XB_TOP      3328
#define XB_TOPGEN   3392
#define XCD_BAR_WORDS 3456
#define XB_SPIN_CAP (1u << 18)

__device__ __forceinline__ unsigned xb_ld(unsigned* p)              { return __hip_atomic_load(p, __ATOMIC_RELAXED, __HIP_MEMORY_SCOPE_AGENT); }
__device__ __forceinline__ unsigned xb_add(unsigned* p, unsigned v) { return __hip_atomic_fetch_add(p, v, __ATOMIC_RELAXED, __HIP_MEMORY_SCOPE_AGENT); }
__device__ __forceinline__ unsigned xb_xcc_id() { return (unsigned)__builtin_amdgcn_s_getreg((3 << 11) | 20) & 0xFu; }
#define XB_SPIN(cond, bar) do { unsigned _sp = 0; while (cond) { __builtin_amdgcn_s_sleep(1); \
    if ((++_sp & 255u) == 0u) { if (xb_ld(&(bar)[XB_TMO])) break; if (_sp > XB_SPIN_CAP) { atomicAdd(&(bar)[XB_TMO], 1u); break; } } } } while (0)

struct XcdBarrier {
    unsigned* bar; unsigned x;
    volatile LAS unsigned* st;
};

__device__ __forceinline__ XcdBarrier xcd_barrier_post(unsigned* bar, volatile LAS unsigned* st) {
    XcdBarrier b; b.bar = bar; b.x = xb_xcc_id(); b.st = st;
    if (threadIdx.x == 0) (void)xb_add(&bar[XB_XCNT(b.x)], 1u);
    return b;
}
__device__ __forceinline__ void xcd_barrier_complete(unsigned* bar, unsigned x, unsigned& nloc, unsigned& nx) {
    const unsigned G = gridDim.x * gridDim.y * gridDim.z;
    unsigned sum, cnt, mine, sp = 0u;
    for (;;) {
        sum = 0u; cnt = 0u; mine = 0u;
#pragma unroll
        for (unsigned j = 0; j < 16; ++j) { const unsigned c = xb_ld(&bar[XB_XCNT(j)]); sum += c; cnt += (c > 0u) ? 1u : 0u; mine = (j == x) ? c : mine; }
        if (sum == G) break;
        __builtin_amdgcn_s_sleep(1);
        if ((++sp & 255u) == 0u) { if (xb_ld(&bar[XB_TMO])) break; if (sp > XB_SPIN_CAP) { atomicAdd(&bar[XB_TMO], 1u); break; } }
    }
    nloc = mine > 0u ? mine : 1u; nx = cnt > 0u ? cnt : 1u;
}

__device__ __forceinline__ void xcd_barrier(const XcdBarrier& b) {
    asm volatile("s_waitcnt vmcnt(0)" ::: "memory");
    __syncthreads();
    if (threadIdx.x == 0) {
        unsigned* bar = b.bar;
        __builtin_amdgcn_s_waitcnt(0);
        unsigned nloc = b.st[0], nx = b.st[1];
        if (nloc == 0u) { xcd_barrier_complete(bar, b.x, nloc, nx); b.st[0] = nloc; b.st[1] = nx; }
        const unsigned old = xb_add(&bar[XB_XSUB(b.x)], 1u);
        const unsigned gen = old / nloc;
        if (old + 1u == (gen + 1u) * nloc) {
            __builtin_amdgcn_fence(__ATOMIC_RELEASE, "agent");
            asm volatile("s_waitcnt vmcnt(0)" ::: "memory");
            const unsigned og = xb_add(&bar[XB_TOP], 1u);
            const unsigned tg = og / nx;
            if (og + 1u == (tg + 1u) * nx) xb_add(&bar[XB_TOPGEN], 1u);
            else XB_SPIN(xb_ld(&bar[XB_TOPGEN]) == tg, bar);
            __builtin_amdgcn_fence(__ATOMIC_ACQUIRE, "agent");
            xb_add(&bar[XB_XGEN(b.x)], 1u);
            asm volatile("s_waitcnt vmcnt(0)" ::: "memory");
        } else {
            XB_SPIN(xb_ld(&bar[XB_XGEN(b.x)]) == gen, bar);
            __builtin_amdgcn_fence(__ATOMIC_ACQUIRE, "agent");
            asm volatile("s_waitcnt vmcnt(0)" ::: "memory");
        }
    }
    __syncthreads();
}
constexpr int DM = 1024, SEQ = 16384, NBATCH = 2, MP = NBATCH * SEQ, DSEQ = 32, DBATCH = 16, MS = DBATCH * DSEQ, MT = MP + MS;
constexpr int DFF = 2816, PAST = 4096, SKV = PAST + DSEQ, FW_LD = 3 * DM + 16;
constexpr float LN_EPS = 1e-5f, DN_ALPHA = 1.4142135623730951f, LOG2E = 1.4426950408889634f;
constexpr float LAM_INIT = 0.35550906759096934f;
constexpr size_t O_YP = 0, O_YS = O_YP + (size_t)MP * DM, O_FKP = O_YS + (size_t)MS * DM, O_FVP = O_FKP + (size_t)MP * DM, O_FLP = O_FVP + (size_t)MP * DM,
                 O_DKP = O_FLP + (size_t)MP * 16, O_DVP = O_DKP + (size_t)MP * DM, O_FKS = O_DVP + (size_t)MP * DM, O_FVS = O_FKS + (size_t)MS * DM, O_FLS = O_FVS + (size_t)MS * DM,
                 O_DKS = O_FLS + (size_t)MS * 16, O_DVS = O_DKS + (size_t)MS * DM, O_END = O_DVS + (size_t)MS * DM;
static_assert(O_END == 170926080ull && O_FVP - O_FKP == (size_t)MP * DM && O_DVP - O_DKP == (size_t)MP * DM && O_FVS - O_FKS == (size_t)MS * DM && O_DVS - O_DKS == (size_t)MS * DM, "output map");
constexpr size_t MiB = 1u << 20;
constexpr size_t WS_CTL = 0, CTL_ZERO_BYTES = 1 * MiB;
constexpr size_t WS_WFIN = 2 * MiB, WS_WFOUT = 8 * MiB, WS_WDIN = 10 * MiB, WS_WDOUT = 16 * MiB, WS_WUP0 = 18 * MiB, WS_WUP1 = 29 * MiB, WS_WDN0 = 40 * MiB, WS_WDN1 = 46 * MiB;
constexpr size_t WS_GP = 52 * MiB, WS_GS = 54 * MiB;
constexpr size_t WS_XN = 64 * MiB;
constexpr size_t WS_Q = 130 * MiB, WS_K = 196 * MiB, WS_V = 262 * MiB;
constexpr size_t WS_H = 130 * MiB;
constexpr size_t WS_O1 = 328 * MiB, WS_O2 = 394 * MiB;
constexpr size_t WS_Y = 460 * MiB;
constexpr size_t WS_X = 592 * MiB;
constexpr size_t WS_END = 724 * MiB;
static_assert(WS_V - WS_K == WS_K - WS_Q && WS_WDN1 + (size_t)DM * DFF * 2 <= WS_GP && WS_GS + (size_t)256 * SKV * 4 <= WS_XN && WS_XN + (size_t)MT * DM * 2 <= WS_Q && WS_H + (size_t)MT * DFF * 2 <= WS_O1 && WS_V + (size_t)MT * DM * 2 <= WS_O1 && WS_X + (size_t)MT * DM * 4 <= WS_END, "d_ws map");
constexpr int CW_BAR = 4096;
constexpr int RING_OFF = 0, RING_BYTES = 131072;
constexpr int PH_LDS = attn_body::ATTN_LDS_BYTES;
constexpr int LDSCTL_OFF = PH_LDS, MISC_OFF = LDSCTL_OFF + 320;
constexpr int LDS_BYTES = PH_LDS + 512;
static_assert(RING_BYTES <= PH_LDS && LDS_BYTES <= 160 * 1024, "LDS map");
constexpr int NWAVES = 8;
struct Args { const float* in[18]; float* out; unsigned char* ws; };
struct Frame {
    LAS unsigned char* lds;
    volatile LAS unsigned* MISC;
    gu32* ctl;
    int tid, lane, wave;
    int vcu, G;
};
__device__ __forceinline__ float wave_sum(float v) {
#pragma unroll
    for (int o = 1; o < 64; o <<= 1) v += __shfl_xor(v, o);
    return v;
}
template <int MODE>
__device__ __forceinline__ void p0_transpose_item(const float* W, int ldw, int K, int nblk, bf16* WT, LAS float* scr, int item, int lane) {
    const int kb = item / nblk, nb = item % nblk, k0 = 64 * kb, n0 = 32 * nb;
    int drow = n0;
    if (MODE == 1) { const int bj = n0 / DFF, rem = n0 % DFF; drow = 256 * (rem / 128) + 128 * bj + (rem % 128); }
#pragma unroll 8
    for (int i = 0; i < 32; ++i) { const int kk = 2 * i + (lane >> 5); scr[kk * 33 + (lane & 31)] = W[(size_t)(k0 + kk) * ldw + n0 + (lane & 31)]; }
    LDS_WAIT(); asm volatile("" ::: "memory");
    const int c = lane & 7;
#pragma unroll
    for (int j = 0; j < 4; ++j) { const int n = (lane >> 3) + 8 * j; const LAS float* s = scr + (8 * c) * 33 + n;
        v4u o; o.x = pk2(s[0 * 33], s[1 * 33]); o.y = pk2(s[2 * 33], s[3 * 33]); o.z = pk2(s[4 * 33], s[5 * 33]); o.w = pk2(s[6 * 33], s[7 * 33]);
        *(GAS v4u*)(WT + (size_t)(drow + n) * K + k0 + 8 * c) = o; }
    LDS_WAIT(); asm volatile("" ::: "memory");
}
__device__ __forceinline__ void p0_prologue(Frame& F, const Args& A, unsigned char* ws, float* out) {
    LAS float* scr = (LAS float*)(F.lds + F.wave * 16384);
    const int gw = F.vcu * NWAVES + F.wave, NGW = F.G * NWAVES;
    constexpr int I_FIN = 16 * 96, I_SQ = 16 * 32, I_UP = 16 * 176, I_DN = 44 * 32;
    constexpr int NITEMS = 2 * I_FIN + 2 * I_SQ + 2 * I_UP + 2 * I_DN;
    for (int it = gw; it < NITEMS; it += NGW) {
        int r = it;
        if (r < I_FIN) { p0_transpose_item<0>(A.in[7], FW_LD, DM, 96, (bf16*)(ws + WS_WFIN), scr, r, F.lane); continue; } r -= I_FIN;
        if (r < I_FIN) { p0_transpose_item<0>(A.in[10], 3 * DM, DM, 96, (bf16*)(ws + WS_WDIN), scr, r, F.lane); continue; } r -= I_FIN;
        if (r < I_SQ) { p0_transpose_item<0>(A.in[9], DM, DM, 32, (bf16*)(ws + WS_WFOUT), scr, r, F.lane); continue; } r -= I_SQ;
        if (r < I_SQ) { p0_transpose_item<0>(A.in[13], DM, DM, 32, (bf16*)(ws + WS_WDOUT), scr, r, F.lane); continue; } r -= I_SQ;
        if (r < I_UP) { p0_transpose_item<1>(A.in[14], 2 * DFF, DM, 176, (bf16*)(ws + WS_WUP0), scr, r, F.lane); continue; } r -= I_UP;
        if (r < I_UP) { p0_transpose_item<1>(A.in[14] + (size_t)DM * 2 * DFF, 2 * DFF, DM, 176, (bf16*)(ws + WS_WUP1), scr, r, F.lane); continue; } r -= I_UP;
        if (r < I_DN) { p0_transpose_item<0>(A.in[15], DM, DFF, 32, (bf16*)(ws + WS_WDN0), scr, r, F.lane); continue; } r -= I_DN;
        p0_transpose_item<0>(A.in[15] + (size_t)DFF * DM, DM, DFF, 32, (bf16*)(ws + WS_WDN1), scr, r, F.lane);
    }
    bf16* XN = (bf16*)(ws + WS_XN);
    for (int m = gw; m < MT; m += NGW) {
        const float* xrow = m < MP ? A.in[0] + (size_t)m * DM : A.in[1] + (size_t)(m - MP) * DM;
        const GAS f32x4* xr = (const GAS f32x4*)xrow + F.lane;
        GAS unsigned long long* o8 = (GAS unsigned long long*)(XN + (size_t)m * DM) + F.lane;
#pragma unroll
        for (int j = 0; j < 4; ++j) { const f32x4 v = xr[64 * j]; o8[64 * j] = (unsigned long long)pk2(v.x, v.y) | ((unsigned long long)pk2(v.z, v.w) << 32); }
    }
    __syncthreads();
    LAS float* wl = (LAS float*)F.lds;
    for (int slot = F.tid; slot < 4096; slot += NWAVES * 64) { const int j = slot >> 6, l = slot & 63; f32x4 v;
#pragma unroll
        for (int e = 0; e < 4; ++e) v[e] = A.in[7][(size_t)(16 * j + 4 * (l >> 4) + e) * FW_LD + 3 * DM + (l & 15)];
        *(LAS f32x4*)(wl + slot * 4) = v; }
    __syncthreads();
    { const int c = F.lane & 15, g = F.lane >> 4; const float bfv = A.in[8][c];
      float* lp = out + O_FLP; float* ls = out + O_FLS;
      for (int rg = gw; rg < MT / 16; rg += NGW) {
        const int row0 = rg * 16;
        const float* xr = (row0 < MP ? A.in[0] + (size_t)row0 * DM : A.in[1] + (size_t)(row0 - MP) * DM) + (size_t)c * DM + 4 * g;
        f32x4 a0 = {0.f, 0.f, 0.f, 0.f}, a1 = a0, a2 = a0, a3 = a0;
#pragma unroll 4
        for (int j = 0; j < 64; ++j) { const f32x4 a = *(const f32x4*)(xr + 16 * j); const f32x4 b = *(const LAS f32x4*)(wl + (j * 64 + F.lane) * 4);
            a0 = __builtin_amdgcn_mfma_f32_16x16x4f32(a[0], b[0], a0, 0, 0, 0); a1 = __builtin_amdgcn_mfma_f32_16x16x4f32(a[1], b[1], a1, 0, 0, 0);
            a2 = __builtin_amdgcn_mfma_f32_16x16x4f32(a[2], b[2], a2, 0, 0, 0); a3 = __builtin_amdgcn_mfma_f32_16x16x4f32(a[3], b[3], a3, 0, 0, 0); }
        const f32x4 s = (a0 + a1) + (a2 + a3);
#pragma unroll
        for (int r = 0; r < 4; ++r) { const float z = s[r] + bfv; const float lf = fminf(z, 0.f) - log1pf(expf(-fabsf(z))); const int row = row0 + 4 * g + r;
            if (row < MP) lp[(size_t)row * 16 + c] = lf; else ls[(size_t)(row - MP) * 16 + c] = lf; }
      } }
    __syncthreads();
}
__device__ __forceinline__ double block_excl_scan(double v, LAS double* sc, int lane, int wave) {
    double inc = v;
#pragma unroll
    for (int o = 1; o < 64; o <<= 1) { const double t = __shfl_up(inc, o); if (lane >= o) inc += t; }
    if (lane == 63) sc[wave] = inc;
    __syncthreads();
    double base = 0.0;
#pragma unroll
    for (int w = 0; w < NWAVES; ++w) if (w < wave) base += sc[w];
    __syncthreads();
    return base + inc - v;
}
__device__ __forceinline__ void p1_scan(Frame& F, const Args& A, unsigned char* ws, const float* out) {
    LAS double* sc = (LAS double*)F.lds;
    for (int sq = F.vcu; sq < 256; sq += F.G) {
        const int s = sq >> 4, h = sq & 15; const float* cl = A.in[4] + (size_t)s * PAST * 16 + h; const float* nl = out + O_FLS + (size_t)s * DSEQ * 16 + h;
        float* G = (float*)(ws + WS_GS) + (size_t)sq * SKV;
        const int j0 = F.tid * 9; double sum = 0.0;
        for (int i = 0; i < 9; ++i) { const int j = j0 + i; if (j < SKV) sum += (double)(j < PAST ? cl[(size_t)j * 16] : nl[(size_t)(j - PAST) * 16]); }
        double run = block_excl_scan(sum, sc, F.lane, F.wave);
        for (int i = 0; i < 9; ++i) { const int j = j0 + i; if (j < SKV) { run += (double)(j < PAST ? cl[(size_t)j * 16] : nl[(size_t)(j - PAST) * 16]); G[j] = (float)(-run * 1.4426950408889634); } }
    }
    for (int sq = F.vcu; sq < 32; sq += F.G) {
        const int b = sq >> 4, h = sq & 15; const float* pl = out + O_FLP + (size_t)b * SEQ * 16 + h;
        float* G = (float*)(ws + WS_GP) + (size_t)sq * SEQ;
        const int j0 = F.tid * 32; double sum = 0.0;
        for (int i = 0; i < 32; ++i) sum += (double)pl[(size_t)(j0 + i) * 16];
        double run = block_excl_scan(sum, sc, F.lane, F.wave);
        for (int i = 0; i < 32; ++i) { run += (double)pl[(size_t)(j0 + i) * 16]; G[j0 + i] = (float)(-run * 1.4426950408889634); }
    }
    __syncthreads();
}
template <bool FINAL>
__device__ __forceinline__ void ln_phase(Frame& F, const float* xres_p, const float* xres_s, const float* Y, const float* gam, const float* bet, float* xo_p, float* xo_s, bf16* XN) {
    const int gw = F.vcu * NWAVES + F.wave, NGW = F.G * NWAVES;
    f32x4 gv[4], bv[4];
#pragma unroll
    for (int j = 0; j < 4; ++j) { gv[j] = ((const f32x4*)gam)[F.lane + 64 * j]; bv[j] = ((const f32x4*)bet)[F.lane + 64 * j]; }
    for (int m = gw; m < MT; m += NGW) {
        const float* xr = m < MP ? xres_p + (size_t)m * DM : xres_s + (size_t)(m - MP) * DM;
        float* xo = m < MP ? xo_p + (size_t)m * DM : xo_s + (size_t)(m - MP) * DM;
        const f32x4* x4 = (const f32x4*)xr + F.lane; const f32x4* y4 = (const f32x4*)(Y + (size_t)m * DM) + F.lane;
        f32x4 v[4]; float s = 0.f;
#pragma unroll
        for (int j = 0; j < 4; ++j) { v[j] = x4[64 * j] * DN_ALPHA + y4[64 * j]; s += (v[j].x + v[j].y) + (v[j].z + v[j].w); }
        const float mean = wave_sum(s) * (1.f / DM); float s2 = 0.f;
#pragma unroll
        for (int j = 0; j < 4; ++j) { v[j] = v[j] - mean; s2 += (v[j].x * v[j].x + v[j].y * v[j].y) + (v[j].z * v[j].z + v[j].w * v[j].w); }
        const float rstd = 1.f / sqrtf(wave_sum(s2) * (1.f / DM) + LN_EPS);
#pragma unroll
        for (int j = 0; j < 4; ++j) { const f32x4 o = v[j] * rstd * gv[j] + bv[j]; ((f32x4*)xo)[F.lane + 64 * j] = o;
            if (!FINAL) ((GAS unsigned long long*)(XN + (size_t)m * DM))[F.lane + 64 * j] = (unsigned long long)pk2(o.x, o.y) | ((unsigned long long)pk2(o.z, o.w) << 32); }
    }
}
__device__ __forceinline__ void diff_combine(Frame& F, const bf16* O1, const bf16* O2, const float* lamp, const float* subg, bf16* XN) {
    const int gw = F.vcu * NWAVES + F.wave, NGW = F.G * NWAVES;
    const float sa = wave_sum(lamp[F.lane] * lamp[64 + F.lane]), sb = wave_sum(lamp[128 + F.lane] * lamp[192 + F.lane]);
    const float lam = expf(sa) - expf(sb) + LAM_INIT;
    float gsc[16];
#pragma unroll
    for (int i = 0; i < 16; ++i) gsc[i] = subg[(16 * F.lane + i) & 127] * (1.0f - LAM_INIT);
    for (int m = gw; m < MT; m += NGW) {
        const v4u* a = (const v4u*)(O1 + (size_t)m * DM + 16 * F.lane); const v4u* b = (const v4u*)(O2 + (size_t)m * DM + 16 * F.lane);
        const v4u a0 = a[0], a1 = a[1], b0 = b[0], b1 = b[1];
        float o[16]; float ss = 0.f;
#pragma unroll
        for (int i = 0; i < 8; ++i) { const unsigned wa = i < 4 ? a0[i & 3] : a1[i & 3], wb = i < 4 ? b0[i & 3] : b1[i & 3];
            o[2 * i] = __uint_as_float(wa << 16) - lam * __uint_as_float(wb << 16); o[2 * i + 1] = __uint_as_float(wa & 0xffff0000u) - lam * __uint_as_float(wb & 0xffff0000u);
            ss += o[2 * i] * o[2 * i] + o[2 * i + 1] * o[2 * i + 1]; }
        ss += __shfl_xor(ss, 1); ss += __shfl_xor(ss, 2); ss += __shfl_xor(ss, 4);
        const float rs = 1.f / sqrtf(ss * (1.f / 128.f) + LN_EPS);
        v4u w0, w1;
        w0.x = pk2(o[0] * rs * gsc[0], o[1] * rs * gsc[1]); w0.y = pk2(o[2] * rs * gsc[2], o[3] * rs * gsc[3]); w0.z = pk2(o[4] * rs * gsc[4], o[5] * rs * gsc[5]); w0.w = pk2(o[6] * rs * gsc[6], o[7] * rs * gsc[7]);
        w1.x = pk2(o[8] * rs * gsc[8], o[9] * rs * gsc[9]); w1.y = pk2(o[10] * rs * gsc[10], o[11] * rs * gsc[11]); w1.z = pk2(o[12] * rs * gsc[12], o[13] * rs * gsc[13]); w1.w = pk2(o[14] * rs * gsc[14], o[15] * rs * gsc[15]);
        v4u* d = (v4u*)(XN + (size_t)m * DM + 16 * F.lane); d[0] = w0; d[1] = w1;
    }
}
namespace samp {
using attn_body::bf16x8; using attn_body::f32x16; using attn_body::crow;
typedef float f32x4s __attribute__((ext_vector_type(4)));
__device__ __forceinline__ unsigned cvtpk(float lo, float hi) { return attn_body::cvtpk_s(lo, hi); }
__device__ __forceinline__ bf16x8 pack8(const f32x4s a, const f32x4s b) { attn_body::u32x4 w; w.x = cvtpk(a[0], a[1]); w.y = cvtpk(a[2], a[3]); w.z = cvtpk(b[0], b[1]); w.w = cvtpk(b[2], b[3]); return __builtin_bit_cast(bf16x8, w); }
#define SMFMA(a, b, c) __builtin_amdgcn_mfma_f32_32x32x16_bf16(a, b, c, 0, 0, 0)
template <int NDB>
__device__ __forceinline__ void softmax_upd(f32x16& p0, f32x16& p1, float& m, float& l, f32x16 (&o)[NDB]) {
    float rm = fmaxf(p0[0], p1[0]);
#pragma unroll
    for (int r = 1; r < 16; ++r) rm = fmaxf(rm, fmaxf(p0[r], p1[r]));
    rm = fmaxf(rm, __shfl_xor(rm, 32));
    const float mn = fmaxf(m, rm), al = __builtin_amdgcn_exp2f(m - mn); float sum = 0.f;
#pragma unroll
    for (int r = 0; r < 16; ++r) { p0[r] = __builtin_amdgcn_exp2f(p0[r] - mn); p1[r] = __builtin_amdgcn_exp2f(p1[r] - mn); sum += p0[r] + p1[r]; }
    l = l * al + sum; m = mn;
#pragma unroll
    for (int d = 0; d < NDB; ++d)
#pragma unroll
        for (int r = 0; r < 16; ++r) o[d][r] *= al;
}
__device__ __forceinline__ bf16x8 pfrag(const f32x16& p, int s) { attn_body::u32x4 w; w.x = cvtpk(p[8 * s], p[8 * s + 1]); w.y = cvtpk(p[8 * s + 2], p[8 * s + 3]); w.z = cvtpk(p[8 * s + 4], p[8 * s + 5]); w.w = cvtpk(p[8 * s + 6], p[8 * s + 7]); return __builtin_bit_cast(bf16x8, w); }

template <int MODE>
__device__ __forceinline__ void sample_unit(Frame& F, int u, const bf16* Qb, const bf16* Kb, const bf16* Vb, bf16* Ob1, bf16* Ob2, const float* cK, const float* cV, const float* Gs) {
    constexpr int DV = MODE == 0 ? 64 : 128, NDB = DV / 32;
    const int lane = F.lane, r32 = lane & 31, hi = lane >> 5, wid = F.wave;
    const int s = u >> 4; int kcol, vcol; float sl2 = 0.f; bf16* Ob = Ob1;
    if (MODE == 0) { const int h = u & 15; kcol = h * 64; vcol = h * 64; }
    else { const int head = (u >> 1) & 7, map = u & 1; kcol = head * 128 + map * 64; vcol = head * 128; sl2 = exp2f(-(float)(head + 1)) * LOG2E; Ob = map ? Ob2 : Ob1; }
    const size_t srow = (size_t)MP + 32 * s;
    bf16x8 qr[4];
#pragma unroll
    for (int d0 = 0; d0 < 4; ++d0) qr[d0] = *(const bf16x8*)(Qb + (srow + r32) * DM + kcol + d0 * 16 + hi * 8);
    float m = -1e30f, l = 0.f; f32x16 o[NDB];
#pragma unroll
    for (int d = 0; d < NDB; ++d) o[d] = f32x16{};
    const float* kbase = cK + (size_t)s * PAST * DM + kcol; const float* vbase = cV + (size_t)s * PAST * DM + vcol;
    const float* gs = Gs + (size_t)u * SKV;
    for (int T = wid; T < PAST / 64; T += NWAVES) {
        f32x16 p0, p1;
#pragma unroll
        for (int g = 0; g < 4; ++g) {
            if (MODE == 0) { const f32x4s b0 = *(const f32x4s*)(gs + 64 * T + 8 * g + 4 * hi), b1 = *(const f32x4s*)(gs + 64 * T + 32 + 8 * g + 4 * hi);
#pragma unroll
                for (int i = 0; i < 4; ++i) { p0[4 * g + i] = b0[i]; p1[4 * g + i] = b1[i]; } }
            else {
#pragma unroll
                for (int i = 0; i < 4; ++i) { const int kv = 64 * T + 8 * g + 4 * hi + i; p0[4 * g + i] = sl2 * (float)(kv - PAST); p1[4 * g + i] = sl2 * (float)(kv + 32 - PAST); } }
        }
#pragma unroll
        for (int d0 = 0; d0 < 4; ++d0) {
            const float* k0p = kbase + (size_t)(64 * T + r32) * DM + 16 * d0 + 8 * hi; const float* k1p = k0p + (size_t)32 * DM;
            const bf16x8 ka = pack8(*(const f32x4s*)k0p, *(const f32x4s*)(k0p + 4)), kb = pack8(*(const f32x4s*)k1p, *(const f32x4s*)(k1p + 4));
            p0 = SMFMA(ka, qr[d0], p0); p1 = SMFMA(kb, qr[d0], p1);
        }
        softmax_upd<NDB>(p0, p1, m, l, o);
#pragma unroll
        for (int hf = 0; hf < 2; ++hf)
#pragma unroll
            for (int ks = 0; ks < 2; ++ks) {
                const bf16x8 pb = pfrag(hf ? p1 : p0, ks);
                const float* vp = vbase + (size_t)(64 * T + 32 * hf + 16 * ks + 4 * hi) * DM + r32;
#pragma unroll
                for (int d = 0; d < NDB; ++d) {
                    f32x4s va, vb;
#pragma unroll
                    for (int j = 0; j < 4; ++j) { va[j] = vp[(size_t)j * DM + 32 * d]; vb[j] = vp[(size_t)(8 + j) * DM + 32 * d]; }
                    o[d] = SMFMA(pack8(va, vb), pb, o[d]);
                }
            }
    }
    if (wid == 0) {
        f32x16 p0, p1;
#pragma unroll
        for (int r = 0; r < 16; ++r) p1[r] = -INFINITY;
#pragma unroll
        for (int g = 0; g < 4; ++g) {
            f32x4s b0 = {0.f, 0.f, 0.f, 0.f};
            if (MODE == 0) b0 = *(const f32x4s*)(gs + PAST + 8 * g + 4 * hi);
#pragma unroll
            for (int i = 0; i < 4; ++i) { const int kv = 8 * g + 4 * hi + i;
                if (MODE == 0) p0[4 * g + i] = kv > r32 ? -INFINITY : b0[i];
                else p0[4 * g + i] = sl2 * (float)(kv <= r32 ? kv : 2 * r32 - kv); }
        }
#pragma unroll
        for (int d0 = 0; d0 < 4; ++d0) { const bf16x8 ka = *(const bf16x8*)(Kb + (srow + r32) * DM + kcol + 16 * d0 + 8 * hi); p0 = SMFMA(ka, qr[d0], p0); }
        softmax_upd<NDB>(p0, p1, m, l, o);
#pragma unroll
        for (int ks = 0; ks < 2; ++ks) {
            const bf16x8 pb = pfrag(p0, ks);
            const bf16* vp = Vb + (srow + 16 * ks + 4 * hi) * DM + vcol + r32;
#pragma unroll
            for (int d = 0; d < NDB; ++d) {
                attn_body::u32x4 w;
#pragma unroll
                for (int jj = 0; jj < 4; ++jj) { const int j = 2 * jj; const unsigned lo = vp[(size_t)(8 * (j >> 2) + (j & 3)) * DM + 32 * d], hh = vp[(size_t)(8 * ((j + 1) >> 2) + ((j + 1) & 3)) * DM + 32 * d]; w[jj] = lo | (hh << 16); }
                o[d] = SMFMA(__builtin_bit_cast(bf16x8, w), pb, o[d]);
            }
        }
    }
    l += __shfl_xor(l, 32);
    LAS float* ml = (LAS float*)F.lds;
    LAS float* ob = (LAS float*)(F.lds + 2048);
    if (hi == 0) { ml[(wid * 32 + r32) * 2] = m; ml[(wid * 32 + r32) * 2 + 1] = l; }
#pragma unroll
    for (int d = 0; d < NDB; ++d)
#pragma unroll
        for (int g = 0; g < 4; ++g) { f32x4s v = {o[d][4 * g], o[d][4 * g + 1], o[d][4 * g + 2], o[d][4 * g + 3]}; *(LAS f32x4s*)(ob + (size_t)(wid * 32 + r32) * DV + 32 * d + 8 * g + 4 * hi) = v; }
    __syncthreads();
    { constexpr int PER = DV / 16; const int q = F.tid >> 4, dg = F.tid & 15;
      float mw[NWAVES], M = -1e30f;
#pragma unroll
      for (int w = 0; w < NWAVES; ++w) { mw[w] = ml[(w * 32 + q) * 2]; M = fmaxf(M, mw[w]); }
      float L = 0.f, acc[PER];
#pragma unroll
      for (int i = 0; i < PER; ++i) acc[i] = 0.f;
#pragma unroll
      for (int w = 0; w < NWAVES; ++w) { const float wg = __builtin_amdgcn_exp2f(mw[w] - M); L += wg * ml[(w * 32 + q) * 2 + 1];
#pragma unroll
          for (int i = 0; i < PER; ++i) acc[i] += wg * ob[(size_t)(w * 32 + q) * DV + dg * PER + i]; }
      const float rl = 1.f / L;
      bf16* op = Ob + (srow + q) * DM + vcol + dg * PER;
#pragma unroll
      for (int i = 0; i < PER; i += 2) *(unsigned*)(op + i) = pk2(acc[i] * rl, acc[i + 1] * rl);
    }
    __syncthreads();
}
#undef SMFMA
}
template <int MODE>
__device__ __forceinline__ void attn_phase(Frame& F, unsigned char* lds_raw, const Args& A, unsigned char* ws) {
    using abf = attn_body::bf16;
    const int v = F.vcu;
    LAS float* tab = (LAS float*)(F.lds + attn_body::LDS_TAB);
    const abf* Qb = (const abf*)(ws + WS_Q); const abf* Kb = (const abf*)(ws + WS_K); const abf* Vb = (const abf*)(ws + WS_V);
    if (MODE == 0) {
        const int bh = v >> 3, s = v & 7, b = bh >> 4, h = bh & 15;
        const float* G = (const float*)(ws + WS_GP) + (size_t)bh * SEQ;
        for (int i = F.tid; i < SEQ / 4; i += NWAVES * 64) *(LAS f32x4*)(tab + 4 * i) = *(const f32x4*)(G + 4 * i);
        __syncthreads();
        const long rowbase = (long)b * SEQ;
#pragma unroll 1
        for (int i = 7; i >= 0; --i) { const int k = i >> 1, qb = (i & 1) ? 16 * k + 15 - s : 16 * k + s;
            attn_body::attn_unit<0, 8>(rowbase, qb, 0, Qb + h * 64, Kb + h * 64, Vb + h * 64, (abf*)(ws + WS_Q) + h * 64, (char*)lds_raw, 0.f); }
    } else {
        const int bvh = v >> 2, s = v & 3, b = bvh >> 5, head = (bvh >> 2) & 7, map = (bvh >> 1) & 1, vh = bvh & 1;
        const float sl2 = exp2f(-(float)(head + 1)) * LOG2E;
        for (int i = F.tid; i < SEQ; i += NWAVES * 64) tab[i] = sl2 * (float)i;
        __syncthreads();
        const long rowbase = (long)b * SEQ; const int qcol = head * 128 + map * 64, vcol = head * 128 + vh * 64;
        abf* Ob = (abf*)(ws + (map ? WS_O2 : WS_O1)) + vcol;
#pragma unroll 1
        for (int i = 15; i >= 0; --i) { const int k = i >> 1, qb = (i & 1) ? 8 * k + 7 - s : 8 * k + s;
            attn_body::attn_unit<1, 8>(rowbase, qb, 0, Qb + qcol, Kb + qcol, Vb + vcol, Ob, (char*)lds_raw, 2.f * sl2); }
    }
    __syncthreads();
    for (int u = v; u < 256; u += F.G) {
        if (MODE == 0) samp::sample_unit<0>(F, u, (const bf16*)(ws + WS_Q), (const bf16*)(ws + WS_K), (const bf16*)(ws + WS_V), (bf16*)(ws + WS_Q), (bf16*)(ws + WS_Q), A.in[2], A.in[3], (const float*)(ws + WS_GS));
        else samp::sample_unit<1>(F, u, (const bf16*)(ws + WS_Q), (const bf16*)(ws + WS_K), (const bf16*)(ws + WS_V), (bf16*)(ws + WS_O1), (bf16*)(ws + WS_O2), A.in[5], A.in[6], nullptr);
    }
}

#ifndef NPHASE
#define NPHASE 99
#endif
__global__ void __launch_bounds__(NWAVES * 64, 2) mk_fwd(Args args) {
    extern __shared__ __attribute__((aligned(16))) unsigned char lds[];
    Frame F;
    F.lds = (LAS unsigned char*)lds;
    F.MISC = (volatile LAS unsigned*)(F.lds + MISC_OFF);
    F.tid = threadIdx.x; F.lane = F.tid & 63; F.wave = __builtin_amdgcn_readfirstlane(F.tid >> 6);
    F.G = gridDim.x; { const int bx = blockIdx.x; F.vcu = (F.G % 8 == 0) ? (bx % 8) * (F.G / 8) + bx / 8 : bx; }
    unsigned char* ws = args.ws; const Args& A = args; float* out = args.out;
    F.ctl = (gu32*)(ws + WS_CTL);
    for (int u = F.tid; u < (LDS_BYTES - LDSCTL_OFF) / 4; u += NWAVES * 64) ((LAS unsigned*)(F.lds + LDSCTL_OFF))[u] = 0u;
    __syncthreads();
    XcdBarrier bar = xcd_barrier_post((unsigned*)(F.ctl + CW_BAR), F.MISC + 8);
#define GRID_BAR() do { xcd_barrier(bar); F.tid = threadIdx.x; asm volatile("" : "+v"(F.tid)); F.lane = F.tid & 63; F.wave = __builtin_amdgcn_readfirstlane(F.tid >> 6); } while (0)
    bf16* XN = (bf16*)(ws + WS_XN); bf16* QB = (bf16*)(ws + WS_Q); bf16* KB = (bf16*)(ws + WS_K); bf16* VB = (bf16*)(ws + WS_V); bf16* HB = (bf16*)(ws + WS_H);
    float* Y = (float*)(ws + WS_Y); float* X = (float*)(ws + WS_X);

    p0_prologue(F, A, ws, out);
    GRID_BAR();
#if NPHASE >= 1
    p1_scan(F, A, ws, out);
    { pg8::Gemm g{XN, (const bf16*)(ws + WS_WFIN), MT, 3 * DM, DM}; pg8::StaticOrder S; S.init(MT, 3 * DM, F.G, (int)blockIdx.x);
      pg8::EpiQKV E{QB, (WS_K - WS_Q) / 2, out + O_FKP, out + O_FKS, attn_body::C2};
      pg8::gemm_phase<pg8::EpiQKV, pg8::StaticOrder, true, true>(F.lds + RING_OFF, g, S, E); }
    GRID_BAR();
#endif
#if NPHASE >= 2
    attn_phase<0>(F, lds, A, ws);
    GRID_BAR();
#endif
#if NPHASE >= 3
    { pg8::Gemm g{QB, (const bf16*)(ws + WS_WFOUT), MT, DM, DM}; pg8::StaticOrder S; S.init(MT, DM, F.G, (int)blockIdx.x);
      pg8::EpiF32 E{Y, DM};
      pg8::gemm_phase<pg8::EpiF32, pg8::StaticOrder, true, true>(F.lds + RING_OFF, g, S, E); }
    GRID_BAR();
    ln_phase<false>(F, A.in[0], A.in[1], Y, A.in[16], A.in[17], X, X + (size_t)MP * DM, XN);
    GRID_BAR();
#endif
#if NPHASE >= 4
    { pg8::Gemm g{XN, (const bf16*)(ws + WS_WUP0), MT, 2 * DFF, DM}; pg8::StaticOrder S; S.init(MT, 2 * DFF, F.G, (int)blockIdx.x);
      pg8::EpiSwiGLU E{HB, DFF};
      pg8::gemm_phase<pg8::EpiSwiGLU, pg8::StaticOrder, true, true>(F.lds + RING_OFF, g, S, E); }
    GRID_BAR();
    { pg8::Gemm g{HB, (const bf16*)(ws + WS_WDN0), MT, DM, DFF}; pg8::StaticOrder S; S.init(MT, DM, F.G, (int)blockIdx.x);
      pg8::EpiF32 E{Y, DM};
      pg8::gemm_phase<pg8::EpiF32, pg8::StaticOrder, true, true>(F.lds + RING_OFF, g, S, E); }
    GRID_BAR();
    ln_phase<false>(F, X, X + (size_t)MP * DM, Y, A.in[16] + DM, A.in[17] + DM, X, X + (size_t)MP * DM, XN);
    GRID_BAR();
#endif
#if NPHASE >= 5
    { pg8::Gemm g{XN, (const bf16*)(ws + WS_WDIN), MT, 3 * DM, DM}; pg8::StaticOrder S; S.init(MT, 3 * DM, F.G, (int)blockIdx.x);
      pg8::EpiQKV E{QB, (WS_K - WS_Q) / 2, out + O_DKP, out + O_DKS, attn_body::C2};
      pg8::gemm_phase<pg8::EpiQKV, pg8::StaticOrder, true, true>(F.lds + RING_OFF, g, S, E); }
    GRID_BAR();
#endif
#if NPHASE >= 6
    attn_phase<1>(F, lds, A, ws);
    GRID_BAR();
    diff_combine(F, (const bf16*)(ws + WS_O1), (const bf16*)(ws + WS_O2), A.in[11], A.in[12], XN);
    GRID_BAR();
#endif
#if NPHASE >= 7
    { pg8::Gemm g{XN, (const bf16*)(ws + WS_WDOUT), MT, DM, DM}; pg8::StaticOrder S; S.init(MT, DM, F.G, (int)blockIdx.x);
      pg8::EpiF32 E{Y, DM};
      pg8::gemm_phase<pg8::EpiF32, pg8::StaticOrder, true, true>(F.lds + RING_OFF, g, S, E); }
    GRID_BAR();
    ln_phase<false>(F, X, X + (size_t)MP * DM, Y, A.in[16] + 2 * DM, A.in[17] + 2 * DM, X, X + (size_t)MP * DM, XN);
    GRID_BAR();
    { pg8::Gemm g{XN, (const bf16*)(ws + WS_WUP1), MT, 2 * DFF, DM}; pg8::StaticOrder S; S.init(MT, 2 * DFF, F.G, (int)blockIdx.x);
      pg8::EpiSwiGLU E{HB, DFF};
      pg8::gemm_phase<pg8::EpiSwiGLU, pg8::StaticOrder, true, true>(F.lds + RING_OFF, g, S, E); }
    GRID_BAR();
    { pg8::Gemm g{HB, (const bf16*)(ws + WS_WDN1), MT, DM, DFF}; pg8::StaticOrder S; S.init(MT, DM, F.G, (int)blockIdx.x);
      pg8::EpiF32 E{Y, DM};
      pg8::gemm_phase<pg8::EpiF32, pg8::StaticOrder, true, true>(F.lds + RING_OFF, g, S, E); }
    GRID_BAR();
    ln_phase<true>(F, X, X + (size_t)MP * DM, Y, A.in[16] + 3 * DM, A.in[17] + 3 * DM, out + O_YP, out + O_YS, XN);
#endif
}

extern "C" void kernel_launch(void* const* d_in, const int* in_sizes, int n_in, void* d_out, int out_size, void* d_ws, size_t ws_size, hipStream_t stream) {
    static int grid = 0;
    if (grid == 0) {
        if (n_in != 18 || (size_t)out_size != O_END || ws_size < WS_END) { fprintf(stderr, "kernel_launch: unexpected shapes (n_in %d out %d ws %zu); nothing launched\n", n_in, out_size, ws_size); grid = -1; return; }
        int dev = 0, cus = 0, per_cu = 0;
        if (hipGetDevice(&dev) != hipSuccess || hipDeviceGetAttribute(&cus, hipDeviceAttributeMultiprocessorCount, dev) != hipSuccess) { grid = -1; return; }
        if (hipFuncSetAttribute((const void*)mk_fwd, hipFuncAttributeMaxDynamicSharedMemorySize, LDS_BYTES) != hipSuccess) { fprintf(stderr, "kernel_launch: hipFuncSetAttribute failed\n"); grid = -1; return; }
        if (hipOccupancyMaxActiveBlocksPerMultiprocessor(&per_cu, (const void*)mk_fwd, NWAVES * 64, LDS_BYTES) != hipSuccess || per_cu < 1) { fprintf(stderr, "kernel_launch: occupancy query says %d blocks per CU\n", per_cu); }
        (void)hipGetLastError();
        grid = cus;
        if (grid != 256) { fprintf(stderr, "kernel_launch: built for 256 CUs, found %d; nothing launched\n", grid); grid = -1; return; }
    }
    if (grid < 0) return;
    if (hipMemsetAsync((char*)d_ws + WS_CTL, 0, CTL_ZERO_BYTES, stream) != hipSuccess) return;
    Args a{};
    for (int i = 0; i < 18; ++i) a.in[i] = (const float*)d_in[i];
    a.out = (float*)d_out; a.ws = (unsigned char*)d_ws;
    hipLaunchKernelGGL(mk_fwd, dim3(grid), dim3(NWAVES * 64), LDS_BYTES, stream, a);
}
```

```cpp
#include <hip/hip_runtime.h>
#include <cstdio>
#include <cstdint>
namespace pg8 {
#define PG8_LAS __attribute__((address_space(3)))
typedef unsigned short bf16_t;
typedef short bf16x8 __attribute__((ext_vector_type(8)));
typedef float f32x4 __attribute__((ext_vector_type(4)));
typedef unsigned u32x4 __attribute__((ext_vector_type(4)));
constexpr int BM = 256, BK = 64, HALF = 128, HTB = HALF * BK * 2  , STAGE_BYTES = 8 * HTB, NXCD = 8, WGM = 8;

__host__ __device__ __forceinline__ int lds_byte(int r, int c) { const int st = (r >> 4) * 2 + (c >> 5), rr = r & 15, cc = c & 31, ob = rr * 64 + cc * 2; return st * 1024 + (ob ^ (((ob >> 9) & 1) << 5)); }
__host__ __device__ __forceinline__ void stage_rc(int b, int& R, int& C) { const int st = b / 1024, sb = b % 1024, swz = sb ^ (((sb >> 9) & 1) << 5); R = (st >> 1) * 16 + swz / 64; C = (st & 1) * 32 + (swz % 64) / 2; }
__host__ __device__ __forceinline__ int perm32(int rho) { const int n = rho >> 4, i = rho & 15; return 8 * (i >> 2) + 4 * n + (i & 3); }

struct Unit { int pm, pn, kt0, nkt; };
struct Gemm { const bf16_t* A; const bf16_t* Bt; int M, N, K; };

struct StaticOrder {
    int nM, nN, nwg, G, c, nkt;
    __host__ __device__ void init(int M, int N, int G_, int c_, int nkt_) { nM = M / BM; nN = N / BM; nwg = nM * nN; G = G_; c = c_; nkt = nkt_; }
    __host__ __device__ bool next(int i, Unit& u) const {
        const long L = (long)i * G + c; if (L >= nwg) return false;
        int wgid = (int)L; { const int q = nwg / NXCD, r = nwg % NXCD, xcd = wgid % NXCD, off = wgid / NXCD; wgid = (xcd < r ? xcd * (q + 1) : r * (q + 1) + (xcd - r) * q) + off; }
        const int nig = WGM * nN, gid = wgid / nig, fm = gid * WGM, gsz = (nM - fm) < WGM ? (nM - fm) : WGM;
        u.pm = fm + ((wgid % nig) % gsz); u.pn = (wgid % nig) / gsz; u.kt0 = 0; u.nkt = nkt; return true;
    }
    __device__ __forceinline__ void a_ready(const Unit&) const {}
    __device__ __forceinline__ void done(const Unit&) const {}
};
struct SplitOrder {
    StaticOrder P; int nP, nN, nSl, KS, G, c;
    __host__ __device__ void init(int Mp, int N, int G_, int c_, int nkt_full, int KS_) { P.init(Mp, N, G_, c_, nkt_full); nP = P.nwg; nN = N / BM; KS = KS_; nSl = nkt_full / KS_; G = G_; c = c_; }
    __host__ __device__ bool next(int i, Unit& u) const {
        const long L = (long)i * G + c;
        if (L < nP) return P.next(i, u);
        const int j = (int)(L - nP); if (j >= 2 * nN * nSl) return false;
        u.pm = 128 + (j & 1); const int r = j >> 1; u.pn = r % nN; u.kt0 = (r / nN) * KS; u.nkt = KS; return true;
    }
    __device__ __forceinline__ void a_ready(const Unit&) const {}
    __device__ __forceinline__ void done(const Unit&) const {}
};
__device__ __forceinline__ unsigned cvt_pk_bf16(float lo, float hi) { unsigned r; asm volatile("v_cvt_pk_bf16_f32 %0, %1, %2" : "=v"(r) : "v"(lo), "v"(hi)); return r; }
typedef float f32x2 __attribute__((ext_vector_type(2)));
struct EpiQKV {
    static constexpr bool PERM = true, AFTER_DRAIN = false;
    bf16_t* Q; size_t qkv_stride; float* okp; float* oks; float qscale; unsigned* nb;
    __device__ __forceinline__ void operator()(const f32x4 (&acc)[2][2][4][2], const Unit& u, int wr, int wc, int fr, int fq) const {
        const int t = u.pn >> 2, colt = (u.pn & 3) * BM; const bool samp = u.pm >= 128;
        bf16_t* base = Q + (size_t)t * qkv_stride;
        float* fbase = samp ? oks + (size_t)(t == 2 ? 512 * 1024 : 0) - (size_t)32768 * 1024 : okp + (size_t)(t == 2 ? 32768 * 1024 : 0);
        const float sc = t == 0 ? qscale : 1.f;
        const int row0 = u.pm * BM + wr * 64 + fr, col0 = colt + wc * 32 + 8 * fq;
        float mx0 = 0.f, mx1 = 0.f;
#pragma unroll
        for (int ai = 0; ai < 2; ++ai)
#pragma unroll
            for (int m = 0; m < 4; ++m) { const int row = row0 + ai * HALF + m * 16;
#pragma unroll
                for (int bj = 0; bj < 2; ++bj) { const f32x4 v0 = acc[ai][bj][m][0] * sc, v1 = acc[ai][bj][m][1] * sc;
                    u32x4 w; w.x = cvt_pk_bf16(v0[0], v0[1]); w.y = cvt_pk_bf16(v0[2], v0[3]); w.z = cvt_pk_bf16(v1[0], v1[1]); w.w = cvt_pk_bf16(v1[2], v1[3]);
                    *(u32x4*)(base + (size_t)row * 1024 + col0 + bj * HALF) = w;
                    if (t != 0 && samp) { float* fp = fbase + (size_t)row * 1024 + col0 + bj * HALF; __builtin_nontemporal_store(v0, (f32x4*)fp); __builtin_nontemporal_store(v1, (f32x4*)(fp + 4)); }
                    if (t != 2 && !samp) { float s = (v0[0] * v0[0] + v0[1] * v0[1]) + (v0[2] * v0[2] + v0[3] * v0[3]) + (v1[0] * v1[0] + v1[1] * v1[1]) + (v1[2] * v1[2] + v1[3] * v1[3]);
                        s += __shfl_xor(s, 16); s += __shfl_xor(s, 32); if (bj == 0) mx0 = fmaxf(mx0, s); else mx1 = fmaxf(mx1, s); } } }
        if (t != 2 && !samp) {
#pragma unroll
            for (int o = 1; o < 16; o <<= 1) { mx0 = fmaxf(mx0, __shfl_xor(mx0, o)); mx1 = fmaxf(mx1, __shfl_xor(mx1, o)); }
            if ((fr | fq) == 0) { unsigned* p = nb + (t * 2 + (u.pm >> 6)) * 32 + (colt + wc * 32) / 32;
                __hip_atomic_fetch_max(p, __float_as_uint(mx0), __ATOMIC_RELAXED, __HIP_MEMORY_SCOPE_AGENT); __hip_atomic_fetch_max(p + 4, __float_as_uint(mx1), __ATOMIC_RELAXED, __HIP_MEMORY_SCOPE_AGENT); }
        }
    }
};
struct EpiBf16 {
    static constexpr bool PERM = true, AFTER_DRAIN = false;
    bf16_t* Y; int ldc;
    __device__ __forceinline__ void operator()(const f32x4 (&acc)[2][2][4][2], const Unit& u, int wr, int wc, int fr, int fq) const {
        const int row0 = u.pm * BM + wr * 64 + fr, col0 = u.pn * BM + wc * 32 + 8 * fq;
#pragma unroll
        for (int ai = 0; ai < 2; ++ai)
#pragma unroll
            for (int m = 0; m < 4; ++m) { bf16_t* rp = Y + (size_t)(row0 + ai * HALF + m * 16) * ldc + col0;
#pragma unroll
                for (int bj = 0; bj < 2; ++bj) { const f32x4 v0 = acc[ai][bj][m][0], v1 = acc[ai][bj][m][1];
                    u32x4 w; w.x = cvt_pk_bf16(v0[0], v0[1]); w.y = cvt_pk_bf16(v0[2], v0[3]); w.z = cvt_pk_bf16(v1[0], v1[1]); w.w = cvt_pk_bf16(v1[2], v1[3]);
                    *(u32x4*)(rp + bj * HALF) = w; } }
    }
};
struct EpiYSplit {
    static constexpr bool PERM = true, AFTER_DRAIN = false;
    bf16_t* Y; float* slab; int ldc, KS;
    __device__ __forceinline__ void operator()(const f32x4 (&acc)[2][2][4][2], const Unit& u, int wr, int wc, int fr, int fq) const {
        const int row0 = u.pm * BM + wr * 64 + fr, col0 = u.pn * BM + wc * 32 + 8 * fq;
        if (u.pm < 128) {
#pragma unroll
            for (int ai = 0; ai < 2; ++ai)
#pragma unroll
                for (int m = 0; m < 4; ++m) { bf16_t* rp = Y + (size_t)(row0 + ai * HALF + m * 16) * ldc + col0;
#pragma unroll
                    for (int bj = 0; bj < 2; ++bj) { const f32x4 v0 = acc[ai][bj][m][0], v1 = acc[ai][bj][m][1];
                        u32x4 w; w.x = cvt_pk_bf16(v0[0], v0[1]); w.y = cvt_pk_bf16(v0[2], v0[3]); w.z = cvt_pk_bf16(v1[0], v1[1]); w.w = cvt_pk_bf16(v1[2], v1[3]);
                        *(u32x4*)(rp + bj * HALF) = w; } }
        } else {
            float* sb = slab + (size_t)(u.kt0 / KS) * 512 * ldc - (size_t)32768 * ldc;
#pragma unroll
            for (int ai = 0; ai < 2; ++ai)
#pragma unroll
                for (int m = 0; m < 4; ++m) { float* rp = sb + (size_t)(row0 + ai * HALF + m * 16) * ldc + col0;
#pragma unroll
                    for (int bj = 0; bj < 2; ++bj) { *(f32x4*)(rp + bj * HALF) = acc[ai][bj][m][0]; *(f32x4*)(rp + bj * HALF + 4) = acc[ai][bj][m][1]; } }
        }
    }
};
struct EpiSwiGLU {
    static constexpr bool PERM = true, AFTER_DRAIN = false;
    bf16_t* H; int ldc;
    __device__ __forceinline__ void operator()(const f32x4 (&acc)[2][2][4][2], const Unit& u, int wr, int wc, int fr, int fq) const {
        const int row0 = u.pm * BM + wr * 64 + fr, col0 = u.pn * HALF + wc * 32 + 8 * fq;
#pragma unroll
        for (int ai = 0; ai < 2; ++ai)
#pragma unroll
            for (int m = 0; m < 4; ++m) { float r[8];
#pragma unroll
                for (int n = 0; n < 2; ++n)
#pragma unroll
                    for (int i = 0; i < 4; ++i) { const float g = acc[ai][0][m][n][i], uu = acc[ai][1][m][n][i];
                        r[4 * n + i] = g * uu * __builtin_amdgcn_rcpf(1.0f + __builtin_amdgcn_exp2f(-1.4426950408889634f * g)); }
                u32x4 w; w.x = cvt_pk_bf16(r[0], r[1]); w.y = cvt_pk_bf16(r[2], r[3]); w.z = cvt_pk_bf16(r[4], r[5]); w.w = cvt_pk_bf16(r[6], r[7]);
                *(u32x4*)(H + (size_t)(row0 + ai * HALF + m * 16) * ldc + col0) = w; }
    }
};
template <class Epi, class Sched, bool ALIGN_EPI = false, bool SP2 = false>
__device__ __forceinline__ void gemm_phase(PG8_LAS unsigned char* lds, const Gemm g, const Sched& S, const Epi& E) {
    int tid_ = threadIdx.x; asm volatile("" : "+v"(tid_));
    const int tid = tid_, wid = __builtin_amdgcn_readfirstlane(tid >> 6), lane = tid & 63, wr = wid >> 2, wc = wid & 3, fr = lane & 15, fq = lane >> 4;
    const int K = g.K;
    unsigned voffA[2], voffB[2];
#pragma unroll
    for (int i = 0; i < 2; ++i) { int R, C; stage_rc(tid * 16 + i * 8192, R, C); const int Rb = Epi::PERM ? ((R & ~31) + perm32(R & 31)) : R;
        voffA[i] = (unsigned)(R * K + C) * 2u; voffB[i] = (unsigned)(Rb * K + C) * 2u; }
    const size_t kstep = (size_t)(BK * 2);
    const size_t hstep = (size_t)HALF * K * 2;
    const size_t tstep = 2 * hstep;
    const unsigned ldsw = (unsigned)wid * 1024u;
    const int aoff = lds_byte(wr * 64 + fr, fq * 8), boff = lds_byte(wc * 32 + fr, fq * 8);
#define PG8_SA(b, h) (((b) * 2 + (h)) * HTB)
#define PG8_SB(b, h) ((4 + (b) * 2 + (h)) * HTB)
#define PG8_STAGE(bufoff, gbase, voff) do { _Pragma("unroll") for (int _i = 0; _i < 2; ++_i) \
        __builtin_amdgcn_global_load_lds((const unsigned*)((const char*)(gbase) + (voff)[_i]), (PG8_LAS unsigned*)(lds + (bufoff) + ldsw + _i * 8192), 16, 0, 0); } while (0)
#define PG8_LDA(dst, b, h) do { _Pragma("unroll") for (int m = 0; m < 4; ++m) _Pragma("unroll") for (int k = 0; k < 2; ++k) dst[m][k] = *(const PG8_LAS bf16x8*)(lds + PG8_SA(b, h) + aoff + m * 2048 + k * 1024); } while (0)
#define PG8_LDB(dst, b, h) do { _Pragma("unroll") for (int n = 0; n < 2; ++n) _Pragma("unroll") for (int k = 0; k < 2; ++k) dst[n][k] = *(const PG8_LAS bf16x8*)(lds + PG8_SB(b, h) + boff + n * 2048 + k * 1024); } while (0)
#define PG8_MMA(ai, bj, At, Bt) do { __builtin_amdgcn_s_setprio(1); _Pragma("unroll") for (int m = 0; m < 4; ++m) _Pragma("unroll") for (int n = 0; n < 2; ++n) _Pragma("unroll") for (int k = 0; k < 2; ++k) \
        acc[ai][bj][m][n] = __builtin_amdgcn_mfma_f32_16x16x32_bf16(Bt[n][k], At[m][k], acc[ai][bj][m][n], 0, 0, 0); __builtin_amdgcn_s_setprio(0); } while (0)
#define PG8_WAIT_V(n) asm volatile("s_waitcnt vmcnt(" #n ")" ::: "memory")
#define PG8_WAIT_L(n) asm volatile("s_waitcnt lgkmcnt(" #n ")" ::: "memory")
#define PG8_BAR __builtin_amdgcn_s_barrier()
#define PG8_SCHED __builtin_amdgcn_sched_barrier(0)
    Unit cur, nxt; int ui = 0;
    if (!S.next(0, cur)) return;
    f32x4 acc[2][2][4][2];
#pragma unroll
    for (int a = 0; a < 2; ++a)
#pragma unroll
        for (int b = 0; b < 2; ++b)
#pragma unroll
            for (int m = 0; m < 4; ++m)
#pragma unroll
                for (int n = 0; n < 2; ++n) acc[a][b][m][n] = (f32x4){0.f, 0.f, 0.f, 0.f};
    bf16x8 At[4][2], B0[2][2], B1[2][2];
    const char* cA = (const char*)g.A + (size_t)cur.pm * tstep + (size_t)cur.kt0 * kstep; const char* cB = (const char*)g.Bt + (size_t)cur.pn * tstep + (size_t)cur.kt0 * kstep;
    S.a_ready(cur);
    if constexpr (SP2) {
        PG8_STAGE(PG8_SB(0, 0), cB, voffB); PG8_STAGE(PG8_SB(0, 1), cB + hstep, voffB); PG8_STAGE(PG8_SA(0, 0), cA, voffA); PG8_STAGE(PG8_SA(0, 1), cA + hstep, voffA);
        if (wr == 1) PG8_BAR;
        PG8_WAIT_V(2); PG8_BAR;
        PG8_STAGE(PG8_SB(1, 0), cB + kstep, voffB); PG8_STAGE(PG8_SA(1, 0), cA + kstep, voffA); PG8_STAGE(PG8_SB(1, 1), cB + hstep + kstep, voffB);
        PG8_WAIT_V(6); PG8_BAR;
    } else {
        PG8_STAGE(PG8_SB(0, 0), cB, voffB); PG8_STAGE(PG8_SA(0, 0), cA, voffA); PG8_STAGE(PG8_SB(0, 1), cB + hstep, voffB); PG8_STAGE(PG8_SA(0, 1), cA + hstep, voffA);
        if (wr == 1) PG8_BAR;
        PG8_WAIT_V(4); PG8_BAR;
        PG8_STAGE(PG8_SB(1, 0), cB + kstep, voffB); PG8_STAGE(PG8_SA(1, 0), cA + kstep, voffA); PG8_STAGE(PG8_SB(1, 1), cB + hstep + kstep, voffB);
        PG8_WAIT_V(6); PG8_BAR;
    }
    for (;;) {
        const bool has_next = S.next(ui + 1, nxt);
        const char* nA = has_next ? (const char*)g.A + (size_t)nxt.pm * tstep + (size_t)nxt.kt0 * kstep : cA; const char* nB = has_next ? (const char*)g.Bt + (size_t)nxt.pn * tstep + (size_t)nxt.kt0 * kstep : cB;
        const int nt = cur.nkt;
        for (int t = 0; t < nt; t += 2) {
            const bool last = (t == nt - 2);
            const char* a1 = cA + (size_t)(t + 1) * kstep;
            const char* a2 = last ? nA : cA + (size_t)(t + 2) * kstep; const char* b2 = last ? nB : cB + (size_t)(t + 2) * kstep;
            const char* a3 = a2 + kstep; const char* b3 = b2 + kstep;
            if (last && has_next) S.a_ready(nxt);
            if constexpr (SP2) {
            PG8_LDB(B0, 0, 0); PG8_LDB(B1, 0, 1); PG8_SCHED; PG8_LDA(At, 0, 0); PG8_STAGE(PG8_SA(1, 1), a1 + hstep, voffA);
            PG8_WAIT_V(8); PG8_WAIT_L(0); PG8_BAR; PG8_MMA(0, 0, At, B0); PG8_MMA(0, 1, At, B1); PG8_BAR; PG8_SCHED;
            PG8_LDA(At, 0, 1); PG8_STAGE(PG8_SB(0, 0), b2, voffB); PG8_STAGE(PG8_SB(0, 1), b2 + hstep, voffB); PG8_STAGE(PG8_SA(0, 0), a2, voffA);
            PG8_WAIT_V(8); PG8_WAIT_L(0); PG8_BAR; PG8_MMA(1, 0, At, B0); PG8_MMA(1, 1, At, B1); PG8_BAR; PG8_SCHED;
            PG8_LDB(B0, 1, 0); PG8_LDB(B1, 1, 1); PG8_SCHED; PG8_LDA(At, 1, 0); PG8_STAGE(PG8_SA(0, 1), a2 + hstep, voffA);
            PG8_WAIT_V(8); PG8_WAIT_L(0); PG8_BAR; PG8_MMA(0, 0, At, B0); PG8_MMA(0, 1, At, B1); PG8_BAR; PG8_SCHED;
            PG8_LDA(At, 1, 1); PG8_STAGE(PG8_SB(1, 0), b3, voffB); PG8_STAGE(PG8_SB(1, 1), b3 + hstep, voffB); PG8_STAGE(PG8_SA(1, 0), a3, voffA);
            PG8_WAIT_V(8); PG8_WAIT_L(0); PG8_BAR; PG8_MMA(1, 0, At, B0); PG8_MMA(1, 1, At, B1); PG8_BAR; PG8_SCHED;
            } else {
            PG8_LDB(B0, 0, 0); PG8_SCHED; PG8_LDA(At, 0, 0); PG8_STAGE(PG8_SA(1, 1), a1 + hstep, voffA);
            PG8_WAIT_L(8); PG8_BAR; PG8_WAIT_L(0); PG8_MMA(0, 0, At, B0); PG8_BAR; PG8_SCHED;
            PG8_LDB(B1, 0, 1); PG8_STAGE(PG8_SB(0, 0), b2, voffB);
            PG8_BAR; PG8_WAIT_L(0); PG8_MMA(0, 1, At, B1); PG8_BAR;
            PG8_LDA(At, 0, 1); PG8_STAGE(PG8_SA(0, 0), a2, voffA);
            PG8_BAR; PG8_WAIT_L(0); PG8_MMA(1, 0, At, B0); PG8_BAR; PG8_SCHED;
            PG8_STAGE(PG8_SB(0, 1), b2 + hstep, voffB);
            PG8_WAIT_V(6); PG8_BAR; PG8_MMA(1, 1, At, B1); PG8_BAR;
            PG8_LDB(B0, 1, 0); PG8_SCHED; PG8_LDA(At, 1, 0); PG8_STAGE(PG8_SA(0, 1), a2 + hstep, voffA);
            PG8_WAIT_L(8); PG8_BAR; PG8_WAIT_L(0); PG8_MMA(0, 0, At, B0); PG8_BAR; PG8_SCHED;
            PG8_LDB(B1, 1, 1); PG8_STAGE(PG8_SB(1, 0), b3, voffB);
            PG8_BAR; PG8_WAIT_L(0); PG8_MMA(0, 1, At, B1); PG8_BAR;
            PG8_LDA(At, 1, 1); PG8_STAGE(PG8_SA(1, 0), a3, voffA);
            PG8_BAR; PG8_WAIT_L(0); PG8_MMA(1, 0, At, B0); PG8_BAR; PG8_SCHED;
            PG8_STAGE(PG8_SB(1, 1), b3 + hstep, voffB);
            PG8_WAIT_V(6); PG8_BAR; PG8_MMA(1, 1, At, B1); PG8_BAR;
            }
        }
        if constexpr (ALIGN_EPI) { if (wr == 0) PG8_BAR; }
        if constexpr (!Epi::AFTER_DRAIN) { E(acc, cur, wr, wc, fr, fq); S.done(cur); }
        if (!has_next) break;
#pragma unroll
        for (int a = 0; a < 2; ++a)
#pragma unroll
            for (int b = 0; b < 2; ++b)
#pragma unroll
                for (int m = 0; m < 4; ++m)
#pragma unroll
                    for (int n = 0; n < 2; ++n) acc[a][b][m][n] = (f32x4){0.f, 0.f, 0.f, 0.f};
        cur = nxt; cA = nA; cB = nB; ++ui;
        if constexpr (ALIGN_EPI) { if (wr == 1) PG8_BAR; }
    }
    PG8_WAIT_V(0);
    if constexpr (!ALIGN_EPI) { if (wr == 0) PG8_BAR; }
    PG8_BAR;
    if constexpr (Epi::AFTER_DRAIN) { E.fused(acc, cur, wr, wc, fr, fq, lds, wid, lane); S.done(cur); }
#undef PG8_SA
#undef PG8_SB
#undef PG8_STAGE
#undef PG8_LDA
#undef PG8_LDB
#undef PG8_MMA
#undef PG8_WAIT_V
#undef PG8_WAIT_L
#undef PG8_BAR
#undef PG8_SCHED
}
}

#ifndef PG8_SP2
#define PG8_SP2 true
#endif
#ifndef PG8_ALIGN
#define PG8_ALIGN true
#endif
#include <hip/hip_bf16.h>
#include <cmath>
namespace attn_body {
using bf16=__hip_bfloat16;
using bf16x8=__attribute__((ext_vector_type(8)))short;
using s16x4=__attribute__((ext_vector_type(4)))short;
using f32x16=__attribute__((ext_vector_type(16)))float;
using u32x4=__attribute__((ext_vector_type(4)))unsigned;
constexpr int BATCH=2,NHEAD=16,SEQ=16384,D=64,DM=NHEAD*D;
constexpr int NW=8,QBLK=32,QB=QBLK*NW,KVBLK=64,NQB=SEQ/QB;
constexpr int ATTN_PITCH=DM, ATTN_UNIT_ROWS=QB;
__device__ __forceinline__ int crow(int r,int hi){return (r&3)+8*(r>>2)+4*hi;}
#define SBAR() __builtin_amdgcn_sched_barrier(0)
__device__ __forceinline__ void cmask(f32x16&p0,f32x16&p1,int jb,int qrel,int hi){
  const float NEG=-INFINITY; int kb=64*jb+4*hi;
  #pragma unroll
  for(int r=0;r<16;++r){int kv=kb+(r&3)+8*(r>>2); if(kv>qrel)p0[r]=NEG; if(kv+32>qrel)p1[r]=NEG;}
}

__device__ __forceinline__ void dmask(f32x16&p0,f32x16&p1,int jb,int qrel,int hi,float s2){
  const float NEG=-INFINITY; const int c=qrel>>6; const int kb=64*jb+4*hi;
  if(jb>c){
    #pragma unroll
    for(int r=0;r<16;++r){p0[r]=NEG;p1[r]=NEG;}
  } else if(jb==c){
    #pragma unroll
    for(int r=0;r<16;++r){const int kv=kb+(r&3)+8*(r>>2); if(kv>qrel)p0[r]+=s2*(float)(qrel-kv); if(kv+32>qrel)p1[r]+=s2*(float)(qrel-kv-32);}
  }
}
typedef float f32x4_t __attribute__((ext_vector_type(4)));
constexpr int NSLOT=3, SLOTB=8192;
constexpr int LDS_K=0, LDS_V=NSLOT*SLOTB, LDS_WS=2*NSLOT*SLOTB, LDS_OST=LDS_WS+NW*64*4, LDS_TAB=LDS_OST+NW*4096, LDS_BYTES=LDS_TAB+SEQ*4;
constexpr float C2=0.125f*1.4426950408889634f;
__device__ __forceinline__ void glds16(const void*gsrc,unsigned lds_dst){unsigned keep;
  asm volatile("s_mov_b32 %0, m0\n\ts_mov_b32 m0, %2\n\ts_nop 0\n\tglobal_load_lds_dwordx4 %1, off\n\ts_mov_b32 m0, %0":"=&s"(keep):"v"(gsrc),"s"(lds_dst):"memory");}
__device__ __forceinline__ float max3f(float a,float b,float c){float r;asm("v_max3_f32 %0, %1, %2, %3":"=v"(r):"v"(a),"v"(b),"v"(c));return r;}
__device__ __forceinline__ float max2f(float a,float b){float r;asm("v_max_f32_e32 %0, %1, %2":"=v"(r):"v"(a),"v"(b));return r;}
__device__ __forceinline__ float fadd_s(float a,float b){float r;asm("v_add_f32_e32 %0, %1, %2":"=v"(r):"v"(a),"v"(b));return r;}
__device__ __forceinline__ float fsub_s(float a,float b){float r;asm("v_sub_f32_e32 %0, %1, %2":"=v"(r):"v"(a),"v"(b));return r;}
typedef float f32x2_t __attribute__((ext_vector_type(2))); typedef __bf16 bf16x2_t __attribute__((ext_vector_type(2)));
__device__ __forceinline__ unsigned cvtpk_s(float lo,float hi){f32x2_t v={lo,hi};bf16x2_t b=__builtin_convertvector(v,bf16x2_t);return __builtin_bit_cast(unsigned,b);}
#define WAIT_BAR(N) asm volatile("s_waitcnt vmcnt(" #N ") lgkmcnt(0)\n\ts_barrier":::"memory")

__device__ __forceinline__ void qkt(f32x16&p0,f32x16&p1,const char*Kslot,const bf16x8*qr,int r32,int hi){
  const char*kb=Kslot+hi*1024+r32*16;
  #pragma unroll
  for(int d0=0;d0<4;++d0){
    const bf16x8 b0=*reinterpret_cast<const bf16x8*>(kb+d0*2048);
    const bf16x8 b1=*reinterpret_cast<const bf16x8*>(kb+d0*2048+512);
    {p0=__builtin_amdgcn_mfma_f32_32x32x16_bf16(b0,qr[d0],p0,0,0,0);p1=__builtin_amdgcn_mfma_f32_32x32x16_bf16(b1,qr[d0],p1,0,0,0);}}
}
typedef __attribute__((address_space(3))) const char* lds_cptr;
typedef short v4i16_t __attribute__((ext_vector_type(4)));
__device__ __forceinline__ void kload8(bf16x8*kf,lds_cptr kp){
  kf[0]=*(const __attribute__((address_space(3))) bf16x8*)(kp);      kf[1]=*(const __attribute__((address_space(3))) bf16x8*)(kp+512);
  kf[2]=*(const __attribute__((address_space(3))) bf16x8*)(kp+2048); kf[3]=*(const __attribute__((address_space(3))) bf16x8*)(kp+2560);
  kf[4]=*(const __attribute__((address_space(3))) bf16x8*)(kp+4096); kf[5]=*(const __attribute__((address_space(3))) bf16x8*)(kp+4608);
  kf[6]=*(const __attribute__((address_space(3))) bf16x8*)(kp+6144); kf[7]=*(const __attribute__((address_space(3))) bf16x8*)(kp+6656);
}
__device__ __forceinline__ void kload2(bf16x8*kf,lds_cptr kp,int j){ kf[2*j]=*(const __attribute__((address_space(3))) bf16x8*)(kp+j*2048); kf[2*j+1]=*(const __attribute__((address_space(3))) bf16x8*)(kp+j*2048+512); }
__device__ __forceinline__ s16x4 vtr(lds_cptr p){ return __builtin_bit_cast(s16x4,__builtin_amdgcn_ds_read_tr16_b64_v4i16((__attribute__((address_space(3))) v4i16_t*)p)); }
__device__ __forceinline__ float rowmax(const f32x16&p0,const f32x16&p1){
  float a=max3f(p0[0],p0[1],p1[0]),b=max3f(p0[2],p0[3],p1[1]);a=max3f(a,p1[2],p1[3]);
  #pragma unroll
  for(int r=4;r<16;r+=4){a=max3f(a,p0[r],p0[r+1]);b=max3f(b,p0[r+2],p0[r+3]);a=max3f(a,p1[r],p1[r+1]);b=max3f(b,p1[r+2],p1[r+3]);}
  const float m=max2f(a,b);
  auto rr=__builtin_amdgcn_permlane32_swap(__float_as_uint(m),__float_as_uint(m),false,false);
  return max2f(__uint_as_float(rr[0]),__uint_as_float(rr[1]));
}
__device__ __forceinline__ void pv(f32x16*o,int vb,bf16x8 pa0,bf16x8 pa1,bf16x8 pa2,bf16x8 pa3){
  #pragma unroll
  for(int d0=0;d0<2;++d0){s16x4 lo[4],hi[4];
    #pragma unroll
    for(int ks=0;ks<4;++ks){
      asm volatile("ds_read_b64_tr_b16 %0,%1 offset:%c2":"=&v"(lo[ks]):"v"(vb),"i"(d0*4096+ks*1024):"memory");
      asm volatile("ds_read_b64_tr_b16 %0,%1 offset:%c2":"=&v"(hi[ks]):"v"(vb),"i"(d0*4096+ks*1024+512):"memory");}
    asm volatile("s_waitcnt lgkmcnt(0)":::"memory");SBAR();
    #define PK(k) (bf16x8){lo[k][0],lo[k][1],lo[k][2],lo[k][3],hi[k][0],hi[k][1],hi[k][2],hi[k][3]}
    o[d0]=__builtin_amdgcn_mfma_f32_32x32x16_bf16(pa0,PK(0),o[d0],0,0,0);
    o[d0]=__builtin_amdgcn_mfma_f32_32x32x16_bf16(pa1,PK(1),o[d0],0,0,0);
    o[d0]=__builtin_amdgcn_mfma_f32_32x32x16_bf16(pa2,PK(2),o[d0],0,0,0);
    o[d0]=__builtin_amdgcn_mfma_f32_32x32x16_bf16(pa3,PK(3),o[d0],0,0,0);
    #undef PK
  }
}

#ifndef ATTN_STORE16
#define ATTN_STORE16(p,v) (*(u32x4*)(p)=(v))
#endif
template<int MODE,int THRL> __device__ __forceinline__ void attn_unit(long rowbase,int qb,int t0,const bf16*Q,const bf16*__restrict__ K,const bf16*__restrict__ V,bf16*O,char*shm,float s2){
  int tid_=threadIdx.x; asm volatile("":"+v"(tid_)); const int tid=tid_,lane=tid&63,r32=lane&31,hi=lane>>5; const int wid=__builtin_amdgcn_readfirstlane(tid>>6);
  const int q0=qb*QB;
  const bf16*Qw=Q+(rowbase+q0+wid*QBLK)*DM;
  const bf16*Kh=K+(rowbase+(long)t0*KVBLK)*DM,*Vh=V+(rowbase+(long)t0*KVBLK)*DM;
  const unsigned lds0=(unsigned)(uintptr_t)shm;
  float*wsf=(float*)(shm+LDS_WS)+wid*64;
  const bf16*ksrc=Kh+(long)lane*DM+wid*8;
  const bf16*vsrc=Vh+(long)(16*(wid&3)+(lane>>2))*DM+(wid>>2)*32+(lane&3)*8;
  const unsigned kdst=lds0+LDS_K+wid*1024, vdst=lds0+LDS_V+wid*1024;
  #define DMA_K(t,slot) glds16(ksrc+(long)(t)*KVBLK*DM,(unsigned)__builtin_amdgcn_readfirstlane(kdst+(slot)))
  #define DMA_V(t,slot) glds16(vsrc+(long)(t)*KVBLK*DM,(unsigned)__builtin_amdgcn_readfirstlane(vdst+(slot)))
  const int vb0=(int)(lds0+LDS_V)+((lane>>4)&1)*32+(lane&3)*8+(4*hi+((lane&15)>>2))*64;
  const char*Kbase=shm+LDS_K; bf16x8 kf[8];
  const lds_cptr shm3=(lds_cptr)shm; const lds_cptr kp0=shm3+LDS_K+hi*1024+r32*16; const lds_cptr vp0=shm3+LDS_V+((lane>>4)&1)*32+(lane&3)*8+(4*hi+((lane&15)>>2))*64;
  const int NT=(q0+QB)/KVBLK-t0;
  DMA_K(0,0);DMA_V(0,0);DMA_K(1,SLOTB);
  bf16x8 qr[4];
  #pragma unroll
  for(int d0=0;d0<4;++d0)qr[d0]=*reinterpret_cast<const bf16x8*>(&Qw[(long)r32*DM+d0*16+hi*8]);
  float mhat=0.f,l_reg=0.f;f32x16 o[2];o[0]=f32x16{};o[1]=f32x16{};
  const u32x4 fbA=hi?u32x4{0x3f803f80u,0x3f80u,0u,0u}:u32x4{0u,0u,0u,0u}; u32x4 fbB=u32x4{0u,0u,0u,0u};
  #define FSPLIT3(x,H,M,L) do{ H=cvtpk_s((x),0.f)&0xffffu; const float r1_=(x)-__uint_as_float(H<<16); M=cvtpk_s(r1_,0.f)&0xffffu; const float r2_=r1_-__uint_as_float(M<<16); L=cvtpk_s(r2_,0.f)&0xffffu; }while(0)
  #define FMUPD() do{ const float nm_=-mhat; unsigned h_,m_,l_; FSPLIT3(nm_,h_,m_,l_); if(hi){ fbB[0]=h_|(m_<<16); fbB[1]=l_; } asm volatile("":"+v"(fbB)); }while(0)
  #define FBMF(C0,C1) do{ C0=__builtin_amdgcn_mfma_f32_32x32x16_bf16(__builtin_bit_cast(bf16x8,fbA),__builtin_bit_cast(bf16x8,fbB),C0,0,0,0); C1=__builtin_amdgcn_mfma_f32_32x32x16_bf16(__builtin_bit_cast(bf16x8,fbA),__builtin_bit_cast(bf16x8,fbB),C1,0,0,0); }while(0)
  const lds_cptr tb3=(lds_cptr)shm+LDS_TAB+t0*256+hi*16;
  #define BLD(C0,C1,t,g_) do{ const __attribute__((address_space(3))) f32x4_t* bp_=(const __attribute__((address_space(3))) f32x4_t*)(tb3+(t)*256); const f32x4_t x0_=bp_[2*(g_)], x1_=bp_[8+2*(g_)]; \
      C0[4*(g_)]=x0_[0];C0[4*(g_)+1]=x0_[1];C0[4*(g_)+2]=x0_[2];C0[4*(g_)+3]=x0_[3]; C1[4*(g_)]=x1_[0];C1[4*(g_)+1]=x1_[1];C1[4*(g_)+2]=x1_[2];C1[4*(g_)+3]=x1_[3]; }while(0)
  #define BLD4(C0,C1,t) do{ BLD(C0,C1,t,0); BLD(C0,C1,t,1); BLD(C0,C1,t,2); BLD(C0,C1,t,3); }while(0)
  const int qrel=wid*QBLK+r32;
  #define CMASK(P0,P1,t) do{int jb_=(t)-(NT-4); if(jb_>=0){ if(MODE==0)cmask(P0,P1,jb_,qrel,hi); else dmask(P0,P1,jb_,qrel,hi,s2);} }while(0)
  bool resc=false; constexpr float TH2_=(float)(1ull<<THRL);
  #define START(P0,P1) do{ const float rm=rowmax(P0,P1); resc=false; mhat=rm; FMUPD(); \
    _Pragma("unroll") for(int r=0;r<16;++r){P0[r]=fsub_s(P0[r],mhat);P1[r]=fsub_s(P1[r],mhat);} \
    _Pragma("unroll") for(int r=0;r<16;++r)P0[r]=__builtin_amdgcn_exp2f(P0[r]); }while(0)
  #define RESC() do{ if(resc){ asm volatile("s_waitcnt lgkmcnt(0)":::"memory"); \
      _Pragma("unroll") for(int d_=0;d_<2;++d_) _Pragma("unroll") for(int r=0;r<16;++r)o[d_][r]*=wsf[crow(r,hi)]; } }while(0)
  f32x16 pA0,pA1,pB0,pB1;
  int sl_prev=0,sl_cur=0,sl_next=SLOTB;
  #define ROT() do{sl_prev=sl_cur;sl_cur=sl_next;sl_next=(sl_next==(NSLOT-1)*SLOTB)?0:sl_next+SLOTB;}while(0)
  DMA_K(2,2*SLOTB);
  WAIT_BAR(3);
  BLD4(pA0,pA1,0); qkt(pA0,pA1,Kbase,qr,r32,hi);asm volatile("s_nop 15\n\ts_nop 7":"+v"(pA0),"+v"(pA1));CMASK(pA0,pA1,0);
  START(pA0,pA1);
  _Pragma("unroll") for(int r=0;r<16;++r)pA1[r]=__builtin_amdgcn_exp2f(pA1[r]);
  WAIT_BAR(0);
  DMA_K(3,0);DMA_V(1,SLOTB);
  ROT();
  kload8(kf,kp0+sl_cur);
  WAIT_BAR(2);
  s16x4 vlo[8],vhi[8]; u32x4 pw0,pw1,pw2,pw3;
  #define PKW(P,B) cvtpk_s(P[B],P[B+1])
  #define PAF(k) __builtin_bit_cast(bf16x8,pw##k)
  #define VFR(i) (bf16x8){vlo[i][0],vlo[i][1],vlo[i][2],vlo[i][3],vhi[i][0],vhi[i][1],vhi[i][2],vhi[i][3]}
  #define PIN(x) asm volatile("":"+v"(x))
  #define MX3(a,b,c) __builtin_fmaxf(__builtin_fmaxf((a),(b)),(c))
  #define GAPA(MF,A0,A1,A2,A3,W0,W1,PW) do{ MF; sa0_+=A0; sa1_+=A1; sa2_+=A2; sa3_+=A3; asm volatile("":"+v"(sa0_),"+v"(sa1_),"+v"(sa2_),"+v"(sa3_)); W0; W1; PIN(PW); SBAR(); }while(0)
  #define EX(v) __builtin_amdgcn_exp2f(v)
  #define GAPB(MF,X,B) do{ MF; X[B]=EX(X[B]); X[B+1]=EX(X[B+1]); X[B+2]=EX(X[B+2]); X[B+3]=EX(X[B+3]); PIN(X); SBAR(); }while(0)
  #define VRD(i) do{ vlo[i]=vtr(vp_+(((i)>>2)*4096+((i)&3)*1024)); vhi[i]=vtr(vp_+(((i)>>2)*4096+((i)&3)*1024+512)); }while(0)
  #define KRD(G,j) do{ if(G){ kload2(kf,kp0+sl_next,j); SBAR(); } }while(0)
  #define STEP(C0,C1,P0,P1,t,GK,GV,GL) do{ SBAR(); \
    const lds_cptr vp_=vp0+sl_prev; \
    VRD(0); SBAR(); float sa0_=P0[0],sa1_=P0[1],sa2_=0.f,sa3_=0.f; \
    GAPA(C0=__builtin_amdgcn_mfma_f32_32x32x16_bf16(kf[0],qr[0],C0,0,0,0), P0[2],P0[3],P0[4],P0[5],     pw0[0]=PKW(P0,0), pw0[1]=PKW(P0,2), pw0); \
    VRD(4); SBAR(); GAPA(C1=__builtin_amdgcn_mfma_f32_32x32x16_bf16(kf[1],qr[0],C1,0,0,0), P0[6],P0[7],P0[8],P0[9],     pw0[2]=PKW(P0,4), pw0[3]=PKW(P0,6), pw0); \
    VRD(1); SBAR(); GAPA(C0=__builtin_amdgcn_mfma_f32_32x32x16_bf16(kf[2],qr[1],C0,0,0,0),   P0[10],P0[11],P0[12],P0[13], pw1[0]=PKW(P0,8), pw1[1]=PKW(P0,10), pw1); \
    VRD(5); SBAR(); GAPA(C1=__builtin_amdgcn_mfma_f32_32x32x16_bf16(kf[3],qr[1],C1,0,0,0),   P0[14],P0[15],P1[0],P1[1],   pw1[2]=PKW(P0,12),pw1[3]=PKW(P0,14), pw1); \
    VRD(2); SBAR(); GAPA(C0=__builtin_amdgcn_mfma_f32_32x32x16_bf16(kf[4],qr[2],C0,0,0,0),   P1[2],P1[3],P1[4],P1[5],     pw2[0]=PKW(P1,0), pw2[1]=PKW(P1,2), pw2); \
    VRD(6); SBAR(); GAPA(C1=__builtin_amdgcn_mfma_f32_32x32x16_bf16(kf[5],qr[2],C1,0,0,0),   P1[6],P1[7],P1[8],P1[9],     pw2[2]=PKW(P1,4), pw2[3]=PKW(P1,6), pw2); \
    VRD(3); SBAR(); GAPA(C0=__builtin_amdgcn_mfma_f32_32x32x16_bf16(kf[6],qr[3],C0,0,0,0),   P1[10],P1[11],P1[12],P1[13], pw3[0]=PKW(P1,8), pw3[1]=PKW(P1,10), pw3); \
    VRD(7); SBAR(); GAPA(C1=__builtin_amdgcn_mfma_f32_32x32x16_bf16(kf[7],qr[3],C1,0,0,0),   P1[14],P1[15],0.f,0.f,       pw3[2]=PKW(P1,12),pw3[3]=PKW(P1,14), pw3); \
    const float sacc=(sa0_+sa1_)+(sa2_+sa3_); l_reg+=sacc; \
    if(GK){DMA_K((t)+3,sl_cur);} if(GV){DMA_V((t)+1,sl_next);} \
    CMASK(C0,C1,t); \
    { resc=false; \
      if(__builtin_expect(__any(sacc>TH2_),0)){ float rs; { auto rr=__builtin_amdgcn_permlane32_swap(__float_as_uint(sacc),__float_as_uint(sacc),false,false); rs=__uint_as_float(rr[0])+__uint_as_float(rr[1]); } \
        const float dl=__builtin_fmaxf(__builtin_amdgcn_logf(rs),0.f); mhat+=dl; FMUPD(); \
        const float f=__builtin_amdgcn_exp2f(-dl); l_reg*=f; if(hi==0)wsf[r32]=f; resc=true; } } \
    FBMF(C0,C1); \
    SBAR(); \
    BLD(P0,P1,(t)+1,0); SBAR(); GAPB(o[0]=__builtin_amdgcn_mfma_f32_32x32x16_bf16(PAF(0),VFR(0),o[0],0,0,0), C0,0); \
    BLD(P0,P1,(t)+1,1); SBAR(); GAPB(o[1]=__builtin_amdgcn_mfma_f32_32x32x16_bf16(PAF(0),VFR(4),o[1],0,0,0), C0,4); \
    KRD(GL,0); GAPB(o[0]=__builtin_amdgcn_mfma_f32_32x32x16_bf16(PAF(1),VFR(1),o[0],0,0,0), C0,8); \
    KRD(GL,1); GAPB(o[1]=__builtin_amdgcn_mfma_f32_32x32x16_bf16(PAF(1),VFR(5),o[1],0,0,0), C0,12); \
    KRD(GL,2); GAPB(o[0]=__builtin_amdgcn_mfma_f32_32x32x16_bf16(PAF(2),VFR(2),o[0],0,0,0), C1,0); \
    KRD(GL,3); GAPB(o[1]=__builtin_amdgcn_mfma_f32_32x32x16_bf16(PAF(2),VFR(6),o[1],0,0,0), C1,4); \
    BLD(P0,P1,(t)+1,2); SBAR(); GAPB(o[0]=__builtin_amdgcn_mfma_f32_32x32x16_bf16(PAF(3),VFR(3),o[0],0,0,0), C1,8); \
    BLD(P0,P1,(t)+1,3); SBAR(); GAPB(o[1]=__builtin_amdgcn_mfma_f32_32x32x16_bf16(PAF(3),VFR(7),o[1],0,0,0), C1,12); \
    }while(0)
  BLD4(pB0,pB1,1);
  int t=1;
  #undef CMASK
  #define CMASK(P0,P1,t) do{}while(0)
  for(;t+5<NT;t+=2){
    STEP(pB0,pB1,pA0,pA1,t,true,true,true);     WAIT_BAR(2); RESC(); ROT();
    STEP(pA0,pA1,pB0,pB1,t+1,true,true,true);   WAIT_BAR(2); RESC(); ROT();
  }
  #undef CMASK
  #define CMASK(P0,P1,t) do{int jb_=(t)-(NT-4); if(jb_>=0){ if(MODE==0)cmask(P0,P1,jb_,qrel,hi); else dmask(P0,P1,jb_,qrel,hi,s2);} }while(0)
  #define ENDW(tt) do{ if((tt)+3<NT){WAIT_BAR(2);} else if((tt)+2<NT){WAIT_BAR(1);} else {WAIT_BAR(0);} }while(0)
  for(;t+1<NT;t+=2){
    STEP(pB0,pB1,pA0,pA1,t,(t+3<NT),(t+1<NT),(t+1<NT));       ENDW(t);   RESC(); ROT();
    STEP(pA0,pA1,pB0,pB1,t+1,(t+4<NT),(t+2<NT),(t+2<NT));     ENDW(t+1); RESC(); ROT();
  }
  STEP(pB0,pB1,pA0,pA1,NT-1,false,false,false); RESC();
  if((wid>>1)>=3){ float sacc=pB0[0]+pB0[1]; _Pragma("unroll") for(int r=2;r<16;++r)sacc+=pB0[r]; _Pragma("unroll") for(int r=0;r<16;++r)sacc+=pB1[r]; l_reg+=sacc;
    pw0=(u32x4){PKW(pB0,0),PKW(pB0,2),PKW(pB0,4),PKW(pB0,6)};pw1=(u32x4){PKW(pB0,8),PKW(pB0,10),PKW(pB0,12),PKW(pB0,14)};pw2=(u32x4){PKW(pB1,0),PKW(pB1,2),PKW(pB1,4),PKW(pB1,6)};pw3=(u32x4){PKW(pB1,8),PKW(pB1,10),PKW(pB1,12),PKW(pB1,14)};
    SBAR(); pv(o,vb0+sl_cur,PAF(0),PAF(1),PAF(2),PAF(3)); }
  #undef PKW
  #undef PAF
  #undef VFR
  #undef PIN
  #undef MX3
  #undef GAPA
  #undef GAPB
  #undef EX
  #undef VRD
  #undef KRD
  #undef STEP
  #undef ENDW
  #undef FSPLIT3
  #undef FMUPD
  #undef FBMF
  {auto rr=__builtin_amdgcn_permlane32_swap(__float_as_uint(l_reg),__float_as_uint(l_reg),false,false);l_reg=__uint_as_float(rr[0])+__uint_as_float(rr[1]);}
  if(hi==0)wsf[32+r32]=l_reg;asm volatile("s_waitcnt lgkmcnt(0)":::"memory");
  float rli[16];
  #pragma unroll
  for(int r=0;r<16;++r)rli[r]=__builtin_amdgcn_rcpf(wsf[32+crow(r,hi)]);
  bf16*Ow=O+(rowbase+q0+wid*QBLK)*DM;
  { bf16*stg=(bf16*)(shm+LDS_OST)+wid*2048;
    #pragma unroll
    for(int r=0;r<16;++r){const int orow=crow(r,hi);
      #pragma unroll
      for(int d0=0;d0<2;++d0)stg[orow*64+d0*32+r32]=__float2bfloat16(o[d0][r]*rli[r]);}
    asm volatile("s_waitcnt lgkmcnt(0)":::"memory");
    #pragma unroll
    for(int i=0;i<4;++i){const int row=i*8+(lane>>3),ch=lane&7; const u32x4 v=*(const u32x4*)(stg+row*64+ch*8); ATTN_STORE16(Ow+(long)row*DM+ch*8,v);} }
  asm volatile("s_waitcnt lgkmcnt(0)\n\ts_barrier":::"memory");
  #undef DMA_K
  #undef DMA_V
  #undef CMASK
  #undef START
  #undef RESC
  #undef BLD
  #undef BLD4
  #undef ROT
}
constexpr int ATTN_LDS_BYTES=LDS_BYTES;
namespace d128 {
constexpr int L_K=0, VSLOT=16384, L_V=NSLOT*SLOTB, L_WS=L_V+NSLOT*VSLOT, L_OST=L_WS+NW*64*4, L_END=L_OST+NW*8192;
static_assert(L_END<=LDS_BYTES,"dv=128 unit LDS layout fits the attention scratch");
}
__device__ __forceinline__ void glds16s(const void*sbase,unsigned voff,unsigned lds_dst){unsigned keep;
  asm volatile("s_mov_b32 %0, m0\n\ts_mov_b32 m0, %3\n\ts_nop 0\n\tglobal_load_lds_dwordx4 %1, %2\n\ts_mov_b32 m0, %0":"=&s"(keep):"v"(voff),"s"(sbase),"s"(lds_dst):"memory");}
template<int THRL> __device__ __forceinline__ void attn_unit_d128(long rowbase,int qb,int t0,const bf16*Q,const bf16*__restrict__ K,const bf16*__restrict__ V,bf16*O,char*shm,float s2){
  using namespace d128;
  int tid_=threadIdx.x; asm volatile("":"+v"(tid_)); const int tid=tid_,lane=tid&63,r32=lane&31,hi=lane>>5; const int wid=__builtin_amdgcn_readfirstlane(tid>>6);
  const int q0=qb*QB;
  const bf16*Qw=Q+(rowbase+q0+wid*QBLK)*DM;
  const bf16*Kh=K+(rowbase+(long)t0*KVBLK)*DM,*Vh=V+(rowbase+(long)t0*KVBLK)*DM;
  const unsigned lds0=(unsigned)(uintptr_t)shm;
  __attribute__((address_space(3))) float*wsf=(__attribute__((address_space(3))) float*)((lds_cptr)shm+L_WS)+wid*64;
  const unsigned koff=(unsigned)(lane*DM+wid*8)*2u;
  const unsigned voff=(unsigned)((16*(wid&3)+(lane>>2))*DM+(wid>>2)*32+(lane&3)*8)*2u;
  const unsigned kdst=lds0+L_K+wid*1024, vdst=lds0+L_V+wid*1024;
  const bool lo4=wid<4;
  #define RFL(x) ((unsigned)__builtin_amdgcn_readfirstlane(x))
  #define DMA_K(t,slot) do{ if(lo4){ glds16s(Kh,koff+(unsigned)(t)*(KVBLK*DM*2),RFL(kdst+(slot))); glds16s(Kh,koff+64u+(unsigned)(t)*(KVBLK*DM*2),RFL(kdst+(slot)+4096)); } }while(0)
  #define DMA_V(t,slot) do{ if(lo4){ glds16s(Vh,voff+(unsigned)(t)*(KVBLK*DM*2),RFL(vdst+2*(slot))); glds16s(Vh,voff+128u+(unsigned)(t)*(KVBLK*DM*2),RFL(vdst+2*(slot)+8192)); \
      glds16s(Vh,voff+64u+(unsigned)(t)*(KVBLK*DM*2),RFL(vdst+2*(slot)+4096)); glds16s(Vh,voff+192u+(unsigned)(t)*(KVBLK*DM*2),RFL(vdst+2*(slot)+12288)); } }while(0)
  const char*Kbase=shm+L_K; bf16x8 kf[8];
  const lds_cptr shm3=(lds_cptr)shm; const lds_cptr kp0=shm3+L_K+hi*1024+r32*16; const lds_cptr vp0=shm3+L_V+((lane>>4)&1)*32+(lane&3)*8+(4*hi+((lane&15)>>2))*64;
  const int NT=(q0+QB)/KVBLK-t0;
  DMA_K(0,0);DMA_V(0,0);DMA_K(1,SLOTB);
  bf16x8 qr[4];
  #pragma unroll
  for(int d0=0;d0<4;++d0)qr[d0]=*reinterpret_cast<const bf16x8*>(&Qw[(long)r32*DM+d0*16+hi*8]);
  float mhat=0.f,l_reg=0.f;f32x16 o[4];o[0]=f32x16{};o[1]=f32x16{};o[2]=f32x16{};o[3]=f32x16{};
  const float sl2_=0.5f*s2; const int bofs_=64*t0-q0;
  #define SPLIT3(x,H,M,L) do{ H=cvtpk_s((x),0.f)&0xffffu; const float r1_=(x)-__uint_as_float(H<<16); M=cvtpk_s(r1_,0.f)&0xffffu; const float r2_=r1_-__uint_as_float(M<<16); L=cvtpk_s(r2_,0.f)&0xffffu; }while(0)
  u32x4 bA0,bA1;
  { unsigned h_,m_,l_,hs_,ms_,ls_; const float st_=64.f*sl2_; SPLIT3(st_,hs_,ms_,ls_);
    const float j0=sl2_*(float)(r32+bofs_), j1=sl2_*(float)(r32+32+bofs_);
    SPLIT3(j0,h_,m_,l_); bA0=hi?u32x4{0x3f803f80u,0x3f80u,0u,0u}:u32x4{h_|(m_<<16),l_|(hs_<<16),ms_|(ls_<<16),0u};
    SPLIT3(j1,h_,m_,l_); bA1=hi?u32x4{0x3f803f80u,0x3f80u,0u,0u}:u32x4{h_|(m_<<16),l_|(hs_<<16),ms_|(ls_<<16),0u}; }
  u32x4 bB=(hi==0)?u32x4{0x3f803f80u,0x3f80u,0u,0u}:u32x4{0u,0u,0u,0u};
  const unsigned lom_=hi?0u:0xffffffffu;
  #define BUPD(t) do{ const unsigned x_=__float_as_uint((float)(t))&lom_; bB[1]=(bB[1]&0xffffu)|x_; bB[2]=__builtin_amdgcn_perm(x_,x_,0x03020302u); }while(0)
  #define MUPD() do{ const float nm_=-mhat; unsigned h_,m_,l_; SPLIT3(nm_,h_,m_,l_); if(hi){ bB[0]=h_|(m_<<16); bB[1]=l_; } asm volatile("":"+v"(bB)); }while(0)
  #define BMF(C0,C1) do{ C0=__builtin_amdgcn_mfma_f32_32x32x16_bf16(__builtin_bit_cast(bf16x8,bA0),__builtin_bit_cast(bf16x8,bB),C0,0,0,0); C1=__builtin_amdgcn_mfma_f32_32x32x16_bf16(__builtin_bit_cast(bf16x8,bA1),__builtin_bit_cast(bf16x8,bB),C1,0,0,0); }while(0)
  #define CMASK(P0,P1,t) do{int jb_=(t)-(NT-4); if(jb_>=0)dmask(P0,P1,jb_,wid*QBLK+r32,hi,2.f*sl2_); }while(0)
  bool resc=false; constexpr float TH2_=(float)(1ull<<THRL);
  #define START(P0,P1) do{ const float rm=rowmax(P0,P1); resc=false; mhat=rm; \
    _Pragma("unroll") for(int r=0;r<16;++r){P0[r]=fsub_s(P0[r],mhat);P1[r]=fsub_s(P1[r],mhat);} \
    MUPD(); \
    _Pragma("unroll") for(int r=0;r<16;++r)P0[r]=__builtin_amdgcn_exp2f(P0[r]); }while(0)
  #define RESC() do{ if(resc){ asm volatile("s_waitcnt lgkmcnt(0)":::"memory"); \
      _Pragma("unroll") for(int d_=0;d_<4;++d_) _Pragma("unroll") for(int r=0;r<16;++r)o[d_][r]*=wsf[crow(r,hi)]; } }while(0)
  f32x16 pA0,pA1,pB0,pB1;
  int sl_prev=0,sl_cur=0,sl_next=SLOTB;
  #define ROT() do{sl_prev=sl_cur;sl_cur=sl_next;sl_next=(sl_next==(NSLOT-1)*SLOTB)?0:sl_next+SLOTB;}while(0)
  DMA_K(2,2*SLOTB);
  WAIT_BAR(8);
  pA0=f32x16{}; pA1=f32x16{}; BUPD(0); qkt(pA0,pA1,Kbase,qr,r32,hi); BMF(pA0,pA1); asm volatile("s_nop 15\n\ts_nop 7":"+v"(pA0),"+v"(pA1)); CMASK(pA0,pA1,0);
  START(pA0,pA1);
  _Pragma("unroll") for(int r=0;r<16;++r)pA1[r]=__builtin_amdgcn_exp2f(pA1[r]);
  WAIT_BAR(0);
  DMA_K(3,0);DMA_V(1,SLOTB);
  ROT();
  kload8(kf,kp0+sl_cur);
  WAIT_BAR(6);
  bf16x8 vfa[8],vfb[8]; u32x4 pw0,pw1,pw2,pw3;
  #define PKW(P,B) cvtpk_s(P[B],P[B+1])
  #define PAF(k) __builtin_bit_cast(bf16x8,pw##k)
  #define PIN(x) asm volatile("":"+v"(x))
  #define MX3(a,b,c) __builtin_fmaxf(__builtin_fmaxf((a),(b)),(c))
  #define GAPA(MF,A0,A1,A2,A3,W0,W1,PW) do{ MF; sa0_+=A0; sa1_+=A1; sa2_+=A2; sa3_+=A3; asm volatile("":"+v"(sa0_),"+v"(sa1_),"+v"(sa2_),"+v"(sa3_)); W0; W1; PIN(PW); SBAR(); }while(0)
  #define EX(v) __builtin_amdgcn_exp2f(v)
  #define VOFF(g) ((((g)&3)*4096)+(((g)>>2)*1024))
  #define VRDF(dst,g) do{ const s16x4 lo_=vtr(vp_+VOFF(g)), hi_=vtr(vp_+VOFF(g)+512); dst=(bf16x8){lo_[0],lo_[1],lo_[2],lo_[3],hi_[0],hi_[1],hi_[2],hi_[3]}; }while(0)
  #define GAPP(MF,X,B,RD) do{ RD; SBAR(); MF; X[B]=EX(X[B]); X[B+1]=EX(X[B+1]); PIN(X); SBAR(); }while(0)
  #define KRD(G,j) do{ if(G){ kload2(kf,kp0+sl_next,j); SBAR(); } }while(0)
  #define PVM(k,db,vf) o[db]=__builtin_amdgcn_mfma_f32_32x32x16_bf16(PAF(k),vf,o[db],0,0,0)
  #define STEP(C0,C1,P0,P1,t,GK,GV,GL) do{ SBAR(); \
    const lds_cptr vp_=vp0+2*sl_prev; const f32x16 zc_=f32x16{}; \
    float sa0_=P0[0],sa1_=P0[1],sa2_=0.f,sa3_=0.f; \
    GAPA(C0=__builtin_amdgcn_mfma_f32_32x32x16_bf16(kf[0],qr[0],zc_,0,0,0), P0[2],P0[3],P0[4],P0[5],     pw0[0]=PKW(P0,0), pw0[1]=PKW(P0,2), pw0); \
    VRDF(vfa[0],0); SBAR(); \
    GAPA(C1=__builtin_amdgcn_mfma_f32_32x32x16_bf16(kf[1],qr[0],zc_,0,0,0), P0[6],P0[7],P0[8],P0[9],     pw0[2]=PKW(P0,4), pw0[3]=PKW(P0,6), pw0); \
    VRDF(vfa[1],1); BUPD(t); PIN(bB); SBAR(); \
    GAPA(C0=__builtin_amdgcn_mfma_f32_32x32x16_bf16(kf[2],qr[1],C0,0,0,0),   P0[10],P0[11],P0[12],P0[13], pw1[0]=PKW(P0,8), pw1[1]=PKW(P0,10), pw1); \
    VRDF(vfa[2],2); SBAR(); \
    GAPA(C1=__builtin_amdgcn_mfma_f32_32x32x16_bf16(kf[3],qr[1],C1,0,0,0),   P0[14],P0[15],P1[0],P1[1],   pw1[2]=PKW(P0,12),pw1[3]=PKW(P0,14), pw1); \
    VRDF(vfa[3],3); SBAR(); \
    GAPA(C0=__builtin_amdgcn_mfma_f32_32x32x16_bf16(kf[4],qr[2],C0,0,0,0),   P1[2],P1[3],P1[4],P1[5],     pw2[0]=PKW(P1,0), pw2[1]=PKW(P1,2), pw2); \
    VRDF(vfa[4],4); SBAR(); \
    GAPA(C1=__builtin_amdgcn_mfma_f32_32x32x16_bf16(kf[5],qr[2],C1,0,0,0),   P1[6],P1[7],P1[8],P1[9],     pw2[2]=PKW(P1,4), pw2[3]=PKW(P1,6), pw2); \
    VRDF(vfa[5],5); SBAR(); \
    GAPA(C0=__builtin_amdgcn_mfma_f32_32x32x16_bf16(kf[6],qr[3],C0,0,0,0),   P1[10],P1[11],P1[12],P1[13], pw3[0]=PKW(P1,8), pw3[1]=PKW(P1,10), pw3); \
    VRDF(vfa[6],6); SBAR(); \
    GAPA(C1=__builtin_amdgcn_mfma_f32_32x32x16_bf16(kf[7],qr[3],C1,0,0,0),   P1[14],P1[15],0.f,0.f,       pw3[2]=PKW(P1,12),pw3[3]=PKW(P1,14), pw3); \
    VRDF(vfa[7],7); SBAR(); \
    const float sacc=(sa0_+sa1_)+(sa2_+sa3_); l_reg+=sacc; \
    { resc=false; \
      if(__builtin_expect(__any(sacc>TH2_),0)){ float rs; { auto rr=__builtin_amdgcn_permlane32_swap(__float_as_uint(sacc),__float_as_uint(sacc),false,false); rs=__uint_as_float(rr[0])+__uint_as_float(rr[1]); } \
        const float dl=__builtin_fmaxf(__builtin_amdgcn_logf(rs),0.f); mhat+=dl; \
        MUPD(); \
        const float f=__builtin_amdgcn_exp2f(-dl); l_reg*=f; if(hi==0)wsf[r32]=f; resc=true; } } \
    BMF(C0,C1); \
    if(GK){DMA_K((t)+3,sl_cur);} if(GV){DMA_V((t)+1,sl_next);} \
    CMASK(C0,C1,t); \
    SBAR(); \
    GAPP(PVM(0,0,vfa[0]), C0,0,  (void)0); VRDF(vfb[0],8); SBAR(); \
    GAPP(PVM(0,1,vfa[1]), C0,2,  (void)0); VRDF(vfb[1],9); SBAR(); \
    GAPP(PVM(0,2,vfa[2]), C0,4,  (void)0); VRDF(vfb[2],10); SBAR(); \
    GAPP(PVM(0,3,vfa[3]), C0,6,  (void)0); VRDF(vfb[3],11); SBAR(); \
    GAPP(PVM(1,0,vfa[4]), C0,8,  (void)0); VRDF(vfb[4],12); SBAR(); \
    GAPP(PVM(1,1,vfa[5]), C0,10, (void)0); VRDF(vfb[5],13); SBAR(); \
    GAPP(PVM(1,2,vfa[6]), C0,12, (void)0); VRDF(vfb[6],14); SBAR(); \
    GAPP(PVM(1,3,vfa[7]), C0,14, (void)0); VRDF(vfb[7],15); SBAR(); \
    GAPP(PVM(2,0,vfb[0]), C1,0,  (void)0); \
    GAPP(PVM(2,1,vfb[1]), C1,2,  (void)0); KRD(GL,0); \
    GAPP(PVM(2,2,vfb[2]), C1,4,  (void)0); \
    GAPP(PVM(2,3,vfb[3]), C1,6,  (void)0); KRD(GL,1); \
    GAPP(PVM(3,0,vfb[4]), C1,8,  (void)0); \
    GAPP(PVM(3,1,vfb[5]), C1,10, (void)0); KRD(GL,2); \
    GAPP(PVM(3,2,vfb[6]), C1,12, (void)0); \
    GAPP(PVM(3,3,vfb[7]), C1,14, (void)0); KRD(GL,3); \
    }while(0)
  int t=1;
  #undef CMASK
  #define CMASK(P0,P1,t) do{}while(0)
  for(;t+5<NT;t+=2){
    STEP(pB0,pB1,pA0,pA1,t,true,true,true);     WAIT_BAR(6); RESC(); ROT();
    STEP(pA0,pA1,pB0,pB1,t+1,true,true,true);   WAIT_BAR(6); RESC(); ROT();
  }
  #undef CMASK
  #define CMASK(P0,P1,t) do{int jb_=(t)-(NT-4); if(jb_>=0)dmask(P0,P1,jb_,wid*QBLK+r32,hi,2.f*sl2_); }while(0)
  #define ENDW(tt) do{ if((tt)+3<NT){WAIT_BAR(6);} else if((tt)+2<NT){WAIT_BAR(4);} else {WAIT_BAR(0);} }while(0)
  for(;t+1<NT;t+=2){
    STEP(pB0,pB1,pA0,pA1,t,(t+3<NT),(t+1<NT),(t+1<NT));       ENDW(t);   RESC(); ROT();
    STEP(pA0,pA1,pB0,pB1,t+1,(t+4<NT),(t+2<NT),(t+2<NT));     ENDW(t+1); RESC(); ROT();
  }
  STEP(pB0,pB1,pA0,pA1,NT-1,false,false,false); RESC();
  if((wid>>1)>=3){ float sacc=pB0[0]+pB0[1]; _Pragma("unroll") for(int r=2;r<16;++r)sacc+=pB0[r]; _Pragma("unroll") for(int r=0;r<16;++r)sacc+=pB1[r]; l_reg+=sacc;
    pw0=(u32x4){PKW(pB0,0),PKW(pB0,2),PKW(pB0,4),PKW(pB0,6)};pw1=(u32x4){PKW(pB0,8),PKW(pB0,10),PKW(pB0,12),PKW(pB0,14)};pw2=(u32x4){PKW(pB1,0),PKW(pB1,2),PKW(pB1,4),PKW(pB1,6)};pw3=(u32x4){PKW(pB1,8),PKW(pB1,10),PKW(pB1,12),PKW(pB1,14)};
    SBAR(); const lds_cptr vp_=vp0+2*sl_cur;
    #pragma unroll
    for(int db=0;db<4;++db){ s16x4 a0=vtr(vp_+db*4096),b0=vtr(vp_+db*4096+512),a1=vtr(vp_+db*4096+1024),b1=vtr(vp_+db*4096+1536),a2=vtr(vp_+db*4096+2048),b2=vtr(vp_+db*4096+2560),a3=vtr(vp_+db*4096+3072),b3=vtr(vp_+db*4096+3584);
      #define PK2(a,b) (bf16x8){a[0],a[1],a[2],a[3],b[0],b[1],b[2],b[3]}
      o[db]=__builtin_amdgcn_mfma_f32_32x32x16_bf16(PAF(0),PK2(a0,b0),o[db],0,0,0); o[db]=__builtin_amdgcn_mfma_f32_32x32x16_bf16(PAF(1),PK2(a1,b1),o[db],0,0,0);
      o[db]=__builtin_amdgcn_mfma_f32_32x32x16_bf16(PAF(2),PK2(a2,b2),o[db],0,0,0); o[db]=__builtin_amdgcn_mfma_f32_32x32x16_bf16(PAF(3),PK2(a3,b3),o[db],0,0,0);
      #undef PK2
    } }
  #undef PKW
  #undef PAF
  #undef PIN
  #undef MX3
  #undef GAPA
  #undef GAPP
  #undef EX
  #undef VOFF
  #undef VRDF
  #undef KRD
  #undef PVM
  #undef STEP
  #undef ENDW
  {auto rr=__builtin_amdgcn_permlane32_swap(__float_as_uint(l_reg),__float_as_uint(l_reg),false,false);l_reg=__uint_as_float(rr[0])+__uint_as_float(rr[1]);}
  if(hi==0)wsf[32+r32]=l_reg;asm volatile("s_waitcnt lgkmcnt(0)":::"memory");
  float rli[16];
  #pragma unroll
  for(int r=0;r<16;++r)rli[r]=__builtin_amdgcn_rcpf(wsf[32+crow(r,hi)]);
  bf16*Ow=O+(rowbase+q0+wid*QBLK)*DM;
  { bf16*stg=(bf16*)(shm+L_OST)+wid*4096;
    #pragma unroll
    for(int r=0;r<16;++r){const int orow=crow(r,hi);
      #pragma unroll
      for(int db=0;db<4;++db)stg[orow*128+db*32+r32]=__float2bfloat16(o[db][r]*rli[r]);}
    asm volatile("s_waitcnt lgkmcnt(0)":::"memory");
    #pragma unroll
    for(int i=0;i<8;++i){const int row=i*4+(lane>>4),ch=lane&15; const u32x4 v=*(const u32x4*)(stg+row*128+ch*8); ATTN_STORE16(Ow+(long)row*DM+ch*8,v);} }
  asm volatile("s_waitcnt lgkmcnt(0)\n\ts_barrier":::"memory");
  #undef DMA_K
  #undef RFL
  #undef DMA_V
  #undef CMASK
  #undef START
  #undef RESC
  #undef ROT
  #undef SPLIT3
  #undef BUPD
  #undef MUPD
  #undef BMF
}
#undef SBAR
#undef WAIT_BAR
}
#define GAS __attribute__((address_space(1)))
#define LAS __attribute__((address_space(3)))
typedef unsigned short bf16;
typedef unsigned v4u __attribute__((ext_vector_type(4)));
typedef float f32x4 __attribute__((ext_vector_type(4)));
typedef short bf16x8 __attribute__((ext_vector_type(8)));
typedef GAS unsigned gu32;
typedef GAS unsigned long long gu64;
#define RLX_AGENT __ATOMIC_RELAXED, __HIP_MEMORY_SCOPE_AGENT
#define LDS_WAIT() asm volatile("s_waitcnt lgkmcnt(0)" ::: "memory")
#define VM_WAIT() asm volatile("s_waitcnt vmcnt(0)" ::: "memory")
__device__ __forceinline__ unsigned long long rt() { return __builtin_amdgcn_s_memrealtime(); }
__device__ __forceinline__ unsigned f2bf(float f) { unsigned u = __builtin_bit_cast(unsigned, f); return (u + 0x7fffu + ((u >> 16) & 1u)) >> 16; }
__device__ __forceinline__ unsigned pk2(float lo, float hi) { return f2bf(lo) | (f2bf(hi) << 16); }

#define XB_TMO      128
#define XB_XCNT(j)  (256  + 64 * (j))
#define XB_XSUB(j)  (1280 + 64 * (j))
#define XB_XGEN(j)  (2304 + 64 * (j))
#define XB_TOP      3328
#define XB_TOPGEN   3392
#define XCD_BAR_WORDS 3456
#define XB_SPIN_CAP (1u << 18)

__device__ __forceinline__ unsigned xb_ld(unsigned* p)              { return __hip_atomic_load(p, __ATOMIC_RELAXED, __HIP_MEMORY_SCOPE_AGENT); }
__device__ __forceinline__ unsigned xb_add(unsigned* p, unsigned v) { return __hip_atomic_fetch_add(p, v, __ATOMIC_RELAXED, __HIP_MEMORY_SCOPE_AGENT); }
__device__ __forceinline__ unsigned xb_xcc_id() { return (unsigned)__builtin_amdgcn_s_getreg((3 << 11) | 20) & 0xFu; }
#define XB_SPIN(cond, bar) do { unsigned _sp = 0; while (cond) { __builtin_amdgcn_s_sleep(1); \
    if ((++_sp & 255u) == 0u) { if (xb_ld(&(bar)[XB_TMO])) break; if (_sp > XB_SPIN_CAP) { atomicAdd(&(bar)[XB_TMO], 1u); break; } } } } while (0)

struct XcdBarrier {
    unsigned* bar; unsigned x;
    volatile LAS unsigned* st;
};

__device__ __forceinline__ XcdBarrier xcd_barrier_post(unsigned* bar, volatile LAS unsigned* st) {
    XcdBarrier b; b.bar = bar; b.x = xb_xcc_id(); b.st = st;
    if (threadIdx.x == 0) (void)xb_add(&bar[XB_XCNT(b.x)], 1u);
    return b;
}
__device__ __forceinline__ void xcd_barrier_complete(unsigned* bar, unsigned x, unsigned& nloc, unsigned& nx) {
    const unsigned G = gridDim.x * gridDim.y * gridDim.z;
    unsigned sum, cnt, mine, sp = 0u;
    for (;;) {
        sum = 0u; cnt = 0u; mine = 0u;
#pragma unroll
        for (unsigned j = 0; j < 16; ++j) { const unsigned c = xb_ld(&bar[XB_XCNT(j)]); sum += c; cnt += (c > 0u) ? 1u : 0u; mine = (j == x) ? c : mine; }
        if (sum == G) break;
        __builtin_amdgcn_s_sleep(1);
        if ((++sp & 255u) == 0u) { if (xb_ld(&bar[XB_TMO])) break; if (sp > XB_SPIN_CAP) { atomicAdd(&bar[XB_TMO], 1u); break; } }
    }
    nloc = mine > 0u ? mine : 1u; nx = cnt > 0u ? cnt : 1u;
}

__device__ __forceinline__ void xcd_barrier(const XcdBarrier& b) {
    asm volatile("s_waitcnt vmcnt(0)" ::: "memory");
    __syncthreads();
    if (threadIdx.x == 0) {
        unsigned* bar = b.bar;
        __builtin_amdgcn_s_waitcnt(0);
        unsigned nloc = b.st[0], nx = b.st[1];
        if (nloc == 0u) { xcd_barrier_complete(bar, b.x, nloc, nx); b.st[0] = nloc; b.st[1] = nx; }
        const unsigned old = xb_add(&bar[XB_XSUB(b.x)], 1u);
        const unsigned gen = old / nloc;
        if (old + 1u == (gen + 1u) * nloc) {
            __builtin_amdgcn_fence(__ATOMIC_RELEASE, "agent");
            asm volatile("s_waitcnt vmcnt(0)" ::: "memory");
            const unsigned og = xb_add(&bar[XB_TOP], 1u);
            const unsigned tg = og / nx;
            if (og + 1u == (tg + 1u) * nx) xb_add(&bar[XB_TOPGEN], 1u);
            else XB_SPIN(xb_ld(&bar[XB_TOPGEN]) == tg, bar);
            __builtin_amdgcn_fence(__ATOMIC_ACQUIRE, "agent");
            xb_add(&bar[XB_XGEN(b.x)], 1u);
            asm volatile("s_waitcnt vmcnt(0)" ::: "memory");
        } else {
            XB_SPIN(xb_ld(&bar[XB_XGEN(b.x)]) == gen, bar);
            __builtin_amdgcn_fence(__ATOMIC_ACQUIRE, "agent");
            asm volatile("s_waitcnt vmcnt(0)" ::: "memory");
        }
    }
    __syncthreads();
}
constexpr int DM = 1024, SEQ = 16384, NBATCH = 2, MP = NBATCH * SEQ, DSEQ = 32, DBATCH = 16, MS = DBATCH * DSEQ, MT = MP + MS;
constexpr int DFF = 2816, PAST = 4096, SKV = PAST + DSEQ, FW_LD = 3 * DM + 16;
constexpr float LN_EPS = 1e-5f, DN_ALPHA = 1.4142135623730951f, LOG2E = 1.4426950408889634f;
constexpr float LAM_INIT = 0.35550906759096934f;
constexpr size_t O_YP = 0, O_YS = O_YP + (size_t)MP * DM, O_FKP = O_YS + (size_t)MS * DM, O_FVP = O_FKP + (size_t)MP * DM, O_FLP = O_FVP + (size_t)MP * DM,
                 O_DKP = O_FLP + (size_t)MP * 16, O_DVP = O_DKP + (size_t)MP * DM, O_FKS = O_DVP + (size_t)MP * DM, O_FVS = O_FKS + (size_t)MS * DM, O_FLS = O_FVS + (size_t)MS * DM,
                 O_DKS = O_FLS + (size_t)MS * 16, O_DVS = O_DKS + (size_t)MS * DM, O_END = O_DVS + (size_t)MS * DM;
static_assert(O_END == 170926080ull && O_FVP - O_FKP == (size_t)MP * DM && O_DVP - O_DKP == (size_t)MP * DM && O_FVS - O_FKS == (size_t)MS * DM && O_DVS - O_DKS == (size_t)MS * DM, "output map");
constexpr size_t MiB = 1u << 20;
constexpr size_t WS_CTL = 0, CTL_ZERO_BYTES = 64 * 1024;
constexpr size_t WS_WFIN = 2 * MiB, WS_WFOUT = 8 * MiB, WS_WDIN = 10 * MiB, WS_WDOUT = 16 * MiB, WS_WUP0 = 18 * MiB, WS_WUP1 = 29 * MiB, WS_WDN0 = 40 * MiB, WS_WDN1 = 46 * MiB;
constexpr size_t WS_GP = 52 * MiB, WS_GS = 54 * MiB;
constexpr size_t WS_XN = 64 * MiB;
constexpr size_t WS_Q = 130 * MiB, WS_K = 196 * MiB, WS_V = 262 * MiB;
constexpr size_t WS_H = 130 * MiB;
constexpr size_t WS_O1 = 328 * MiB, WS_O2 = 394 * MiB;
constexpr size_t WS_Y = 460 * MiB;
constexpr size_t WS_X = 592 * MiB;
constexpr size_t WS_END = 724 * MiB;
static_assert(WS_V - WS_K == WS_K - WS_Q && WS_WDN1 + (size_t)DM * DFF * 2 <= WS_GP && WS_GS + (size_t)256 * SKV * 4 <= WS_XN && WS_XN + (size_t)MT * DM * 2 <= WS_Q && WS_H + (size_t)MT * DFF * 2 <= WS_O1 && WS_V + (size_t)MT * DM * 2 <= WS_O1 && WS_X + (size_t)MT * DM * 4 <= WS_END, "d_ws map");
constexpr int CW_BAR = 4096, CW_NB = 8192, CW_QUEUE = 12288;
constexpr int RING_OFF = 0, RING_BYTES = 131072;
constexpr int PH_LDS = attn_body::ATTN_LDS_BYTES;
constexpr int LDSCTL_OFF = PH_LDS, MISC_OFF = LDSCTL_OFF + 320;
constexpr int LDS_BYTES = PH_LDS + 512;
static_assert(RING_BYTES <= PH_LDS && LDS_BYTES <= 160 * 1024, "LDS map");
constexpr int NWAVES = 8;
struct Args { const float* in[18]; float* out; unsigned char* ws; };
struct Frame {
    LAS unsigned char* lds;
    volatile LAS unsigned* MISC;
    gu32* ctl;
    int tid, lane, wave;
    int vcu, G;
};
__device__ __forceinline__ float wave_sum(float v) {
#pragma unroll
    for (int o = 1; o < 64; o <<= 1) v += __shfl_xor(v, o);
    return v;
}
template <int MODE>
__device__ __forceinline__ void p0_transpose_item(const float* W, int ldw, int K, int nblk, bf16* WT, LAS float* scr, int item, int lane) {
    const int kb = item / nblk, nb = item % nblk, k0 = 64 * kb, n0 = 32 * nb;
    int drow = n0;
    if (MODE == 1) { const int bj = n0 / DFF, rem = n0 % DFF; drow = 256 * (rem / 128) + 128 * bj + (rem % 128); }
#pragma unroll 8
    for (int i = 0; i < 32; ++i) { const int kk = 2 * i + (lane >> 5); scr[kk * 33 + (lane & 31)] = W[(size_t)(k0 + kk) * ldw + n0 + (lane & 31)]; }
    LDS_WAIT(); asm volatile("" ::: "memory");
    const int c = lane & 7;
#pragma unroll
    for (int j = 0; j < 4; ++j) { const int n = (lane >> 3) + 8 * j; const LAS float* s = scr + (8 * c) * 33 + n;
        v4u o; o.x = pk2(s[0 * 33], s[1 * 33]); o.y = pk2(s[2 * 33], s[3 * 33]); o.z = pk2(s[4 * 33], s[5 * 33]); o.w = pk2(s[6 * 33], s[7 * 33]);
        *(GAS v4u*)(WT + (size_t)(drow + n) * K + k0 + 8 * c) = o; }
    LDS_WAIT(); asm volatile("" ::: "memory");
}
constexpr int I_FIN = 16 * 96, I_SQ = 16 * 32, I_UP = 16 * 176, I_DN = 44 * 32;
constexpr int TI_A = I_FIN, TI_B = TI_A + I_FIN + I_SQ + I_UP + I_DN, TI_END = TI_B + I_SQ + I_UP + I_DN;
__device__ __forceinline__ void p0_item(const Args& A, unsigned char* ws, LAS float* scr, int it, int lane) {
    int r = it;
    if (r < I_FIN) { p0_transpose_item<0>(A.in[7], FW_LD, DM, 96, (bf16*)(ws + WS_WFIN), scr, r, lane); return; } r -= I_FIN;
    if (r < I_FIN) { p0_transpose_item<0>(A.in[10], 3 * DM, DM, 96, (bf16*)(ws + WS_WDIN), scr, r, lane); return; } r -= I_FIN;
    if (r < I_SQ) { p0_transpose_item<0>(A.in[9], DM, DM, 32, (bf16*)(ws + WS_WFOUT), scr, r, lane); return; } r -= I_SQ;
    if (r < I_UP) { p0_transpose_item<1>(A.in[14], 2 * DFF, DM, 176, (bf16*)(ws + WS_WUP0), scr, r, lane); return; } r -= I_UP;
    if (r < I_DN) { p0_transpose_item<0>(A.in[15], DM, DFF, 32, (bf16*)(ws + WS_WDN0), scr, r, lane); return; } r -= I_DN;
    if (r < I_SQ) { p0_transpose_item<0>(A.in[13], DM, DM, 32, (bf16*)(ws + WS_WDOUT), scr, r, lane); return; } r -= I_SQ;
    if (r < I_UP) { p0_transpose_item<1>(A.in[14] + (size_t)DM * 2 * DFF, 2 * DFF, DM, 176, (bf16*)(ws + WS_WUP1), scr, r, lane); return; } r -= I_UP;
    p0_transpose_item<0>(A.in[15] + (size_t)DFF * DM, DM, DFF, 32, (bf16*)(ws + WS_WDN1), scr, r, lane);
}
__device__ __forceinline__ void p0_tail_items(Frame& F, const Args& A, unsigned char* ws, int nlong, int lo, int hi) {
    const int rank = (int)blockIdx.x - nlong; if (rank < 0) return;
    __syncthreads();
    LAS float* scr = (LAS float*)(F.lds + F.wave * 16384);
    const int stride = (F.G - nlong) * NWAVES;
    for (int it = lo + rank * NWAVES + F.wave; it < hi; it += stride) p0_item(A, ws, scr, it, F.lane);
}
__device__ __forceinline__ void p0_prologue(Frame& F, const Args& A, unsigned char* ws, float* out) {
    LAS float* scr = (LAS float*)(F.lds + F.wave * 16384);
    const int gw = F.vcu * NWAVES + F.wave, NGW = F.G * NWAVES;
    for (int it = gw; it < TI_A; it += NGW) p0_item(A, ws, scr, it, F.lane);
    bf16* XN = (bf16*)(ws + WS_XN);
    for (int m0 = gw; m0 < MT; m0 += 2 * NGW) {
        f32x4 v[2][4];
#pragma unroll
        for (int h = 0; h < 2; ++h) { const int m = m0 + h * NGW; if (m < MT) { const float* xrow = m < MP ? A.in[0] + (size_t)m * DM : A.in[1] + (size_t)(m - MP) * DM;
            const GAS f32x4* xr = (const GAS f32x4*)xrow + F.lane;
#pragma unroll
            for (int j = 0; j < 4; ++j) v[h][j] = xr[64 * j]; } }
#pragma unroll
        for (int h = 0; h < 2; ++h) { const int m = m0 + h * NGW; if (m < MT) { GAS unsigned long long* o8 = (GAS unsigned long long*)(XN + (size_t)m * DM) + F.lane;
#pragma unroll
            for (int j = 0; j < 4; ++j) o8[64 * j] = (unsigned long long)pk2(v[h][j].x, v[h][j].y) | ((unsigned long long)pk2(v[h][j].z, v[h][j].w) << 32); } }
    }
    __syncthreads();
    __syncthreads();
    LAS float* wl = (LAS float*)F.lds;
    for (int slot = F.tid; slot < 4096; slot += NWAVES * 64) { const int j = slot >> 6, l = slot & 63; f32x4 v;
#pragma unroll
        for (int e = 0; e < 4; ++e) v[e] = A.in[7][(size_t)(16 * j + 4 * (l >> 4) + e) * FW_LD + 3 * DM + (l & 15)];
        *(LAS f32x4*)(wl + slot * 4) = v; }
    __syncthreads();
    { const int c = F.lane & 15, g = F.lane >> 4; const float bfv = A.in[8][c];
      float* lp = out + O_FLP; float* ls = out + O_FLS;
      for (int rg = gw; rg < MT / 16; rg += NGW) {
        const int row0 = rg * 16;
        const float* xr = (row0 < MP ? A.in[0] + (size_t)row0 * DM : A.in[1] + (size_t)(row0 - MP) * DM) + (size_t)c * DM + 4 * g;
        f32x4 a0 = {0.f, 0.f, 0.f, 0.f}, a1 = a0, a2 = a0, a3 = a0;
#pragma unroll 16
        for (int j = 0; j < 64; ++j) { const f32x4 a = *(const f32x4*)(xr + 16 * j); const f32x4 b = *(const LAS f32x4*)(wl + (j * 64 + F.lane) * 4);
            a0 = __builtin_amdgcn_mfma_f32_16x16x4f32(a[0], b[0], a0, 0, 0, 0); a1 = __builtin_amdgcn_mfma_f32_16x16x4f32(a[1], b[1], a1, 0, 0, 0);
            a2 = __builtin_amdgcn_mfma_f32_16x16x4f32(a[2], b[2], a2, 0, 0, 0); a3 = __builtin_amdgcn_mfma_f32_16x16x4f32(a[3], b[3], a3, 0, 0, 0); }
        const f32x4 s = (a0 + a1) + (a2 + a3);
#pragma unroll
        for (int r = 0; r < 4; ++r) { const float z = s[r] + bfv; const float lf = fminf(z, 0.f) - log1pf(expf(-fabsf(z))); const int row = row0 + 4 * g + r;
            if (row < MP) lp[(size_t)row * 16 + c] = lf; else ls[(size_t)(row - MP) * 16 + c] = lf; }
      } }
    __syncthreads();
}
__device__ __forceinline__ double block_excl_scan(double v, LAS double* sc, int lane, int wave) {
    double inc = v;
#pragma unroll
    for (int o = 1; o < 64; o <<= 1) { const double t = __shfl_up(inc, o); if (lane >= o) inc += t; }
    if (lane == 63) sc[wave] = inc;
    __syncthreads();
    double base = 0.0;
#pragma unroll
    for (int w = 0; w < NWAVES; ++w) if (w < wave) base += sc[w];
    __syncthreads();
    return base + inc - v;
}
__device__ __forceinline__ void p1_scan(Frame& F, const Args& A, unsigned char* ws, const float* out) {
    LAS double* sc = (LAS double*)F.lds;
    for (int sq = F.vcu; sq < 256; sq += F.G) {
        const int s = sq >> 4, h = sq & 15; const float* cl = A.in[4] + (size_t)s * PAST * 16 + h; const float* nl = out + O_FLS + (size_t)s * DSEQ * 16 + h;
        float* G = (float*)(ws + WS_GS) + (size_t)sq * SKV;
        const int j0 = F.tid * 9; double sum = 0.0;
        for (int i = 0; i < 9; ++i) { const int j = j0 + i; if (j < SKV) sum += (double)(j < PAST ? cl[(size_t)j * 16] : nl[(size_t)(j - PAST) * 16]); }
        double run = block_excl_scan(sum, sc, F.lane, F.wave);
        for (int i = 0; i < 9; ++i) { const int j = j0 + i; if (j < SKV) { run += (double)(j < PAST ? cl[(size_t)j * 16] : nl[(size_t)(j - PAST) * 16]); G[j] = (float)(-run * 1.4426950408889634); } }
    }
    for (int sq = F.vcu; sq < 32; sq += F.G) {
        const int b = sq >> 4, h = sq & 15; const float* pl = out + O_FLP + (size_t)b * SEQ * 16 + h;
        float* G = (float*)(ws + WS_GP) + (size_t)sq * SEQ;
        const int j0 = F.tid * 32; double sum = 0.0;
        for (int i = 0; i < 32; ++i) sum += (double)pl[(size_t)(j0 + i) * 16];
        double run = block_excl_scan(sum, sc, F.lane, F.wave);
        for (int i = 0; i < 32; ++i) { run += (double)pl[(size_t)(j0 + i) * 16]; G[j0 + i] = (float)(-run * 1.4426950408889634); }
    }
    __syncthreads();
}
__device__ __forceinline__ void unpk8(const v4u w, float (&f)[8]) {
#pragma unroll
    for (int i = 0; i < 4; ++i) { f[2 * i] = __uint_as_float(w[i] << 16); f[2 * i + 1] = __uint_as_float(w[i] & 0xffff0000u); }
}
template <bool FINAL>
__device__ __forceinline__ void ln_finish(Frame& F, float (&v)[16], const f32x4 (&gv)[4], const f32x4 (&bv)[4], v4u* xr, float* xo) {
    float s = 0.f;
#pragma unroll
    for (int i = 0; i < 16; ++i) s += v[i];
    const float mean = wave_sum(s) * (1.f / DM); float s2 = 0.f;
#pragma unroll
    for (int i = 0; i < 16; ++i) { v[i] -= mean; s2 += v[i] * v[i]; }
    const float rstd = 1.f / sqrtf(wave_sum(s2) * (1.f / DM) + LN_EPS);
#pragma unroll
    for (int j = 0; j < 2; ++j) {
        f32x4 o0, o1;
#pragma unroll
        for (int i = 0; i < 4; ++i) { o0[i] = v[8 * j + i] * rstd * gv[2 * j][i] + bv[2 * j][i]; o1[i] = v[8 * j + 4 + i] * rstd * gv[2 * j + 1][i] + bv[2 * j + 1][i]; }
        if (FINAL) { float* o = xo + 8 * F.lane + 512 * j; __builtin_nontemporal_store(o0, (f32x4*)o); __builtin_nontemporal_store(o1, (f32x4*)(o + 4)); }
        else { v4u w; w.x = pk2(o0[0], o0[1]); w.y = pk2(o0[2], o0[3]); w.z = pk2(o1[0], o1[1]); w.w = pk2(o1[2], o1[3]); xr[64 * j] = w; }
    }
}
__device__ __forceinline__ void ln_mix(const v4u x0, const v4u x1, const v4u y0, const v4u y1, float (&v)[16]) {
    float xf[8], yf[8];
    unpk8(x0, xf); unpk8(y0, yf);
#pragma unroll
    for (int i = 0; i < 8; ++i) v[i] = xf[i] * DN_ALPHA + yf[i];
    unpk8(x1, xf); unpk8(y1, yf);
#pragma unroll
    for (int i = 0; i < 8; ++i) v[8 + i] = xf[i] * DN_ALPHA + yf[i];
}
template <bool FINAL, int NSLAB>
__device__ __forceinline__ void ln_phase(Frame& F, bf16* XN, const bf16* Y, const float* slab, const float* gam, const float* bet, float* xo_p, float* xo_s) {
    const int gw = F.vcu * NWAVES + F.wave, NGW = F.G * NWAVES;
    f32x4 gv[4], bv[4];
#pragma unroll
    for (int j = 0; j < 2; ++j) { gv[2 * j] = ((const f32x4*)gam)[2 * F.lane + 128 * j]; gv[2 * j + 1] = ((const f32x4*)gam)[2 * F.lane + 128 * j + 1];
                                  bv[2 * j] = ((const f32x4*)bet)[2 * F.lane + 128 * j]; bv[2 * j + 1] = ((const f32x4*)bet)[2 * F.lane + 128 * j + 1]; }
    for (int m = gw; m < MP; m += 2 * NGW) {
        const int mb = m + NGW;
        v4u* xa = (v4u*)(XN + (size_t)m * DM) + F.lane; const v4u* ya = (const v4u*)(Y + (size_t)m * DM) + F.lane;
        v4u* xb = (v4u*)(XN + (size_t)mb * DM) + F.lane; const v4u* yb = (const v4u*)(Y + (size_t)mb * DM) + F.lane;
        const bool hb = mb < MP;
        const v4u xa0 = xa[0], xa1 = xa[64], ya0 = ya[0], ya1 = ya[64];
        v4u xb0 = xa0, xb1 = xa1, yb0 = ya0, yb1 = ya1;
        if (hb) { xb0 = xb[0]; xb1 = xb[64]; yb0 = yb[0]; yb1 = yb[64]; }
        float v[16];
        ln_mix(xa0, xa1, ya0, ya1, v); ln_finish<FINAL>(F, v, gv, bv, xa, xo_p + (size_t)m * DM);
        if (hb) { ln_mix(xb0, xb1, yb0, yb1, v); ln_finish<FINAL>(F, v, gv, bv, xb, xo_p + (size_t)mb * DM); }
    }
    for (int m = MP + gw; m < MT; m += NGW) {
        v4u* xr = (v4u*)(XN + (size_t)m * DM) + F.lane;
        const v4u x0 = xr[0], x1 = xr[64];
        float xf[8], v[16];
        unpk8(x0, xf);
#pragma unroll
        for (int i = 0; i < 8; ++i) v[i] = xf[i] * DN_ALPHA;
        unpk8(x1, xf);
#pragma unroll
        for (int i = 0; i < 8; ++i) v[8 + i] = xf[i] * DN_ALPHA;
        const float* sp = slab + (size_t)(m - MP) * DM + 8 * F.lane;
#pragma unroll
        for (int sl = 0; sl < NSLAB; ++sl) { const f32x4 a0 = *(const f32x4*)(sp + (size_t)sl * MS * DM), a1 = *(const f32x4*)(sp + (size_t)sl * MS * DM + 4), a2 = *(const f32x4*)(sp + (size_t)sl * MS * DM + 512), a3 = *(const f32x4*)(sp + (size_t)sl * MS * DM + 516);
#pragma unroll
            for (int i = 0; i < 4; ++i) { v[i] += a0[i]; v[4 + i] += a1[i]; v[8 + i] += a2[i]; v[12 + i] += a3[i]; } }
        ln_finish<FINAL>(F, v, gv, bv, xr, xo_s + (size_t)(m - MP) * DM);
    }
}
__device__ __forceinline__ void diff_combine(Frame& F, const bf16* O1, const bf16* O2, const float* lamp, const float* subg, bf16* XN) {
    const int gw = F.vcu * NWAVES + F.wave, NGW = F.G * NWAVES;
    const float sa = wave_sum(lamp[F.lane] * lamp[64 + F.lane]), sb = wave_sum(lamp[128 + F.lane] * lamp[192 + F.lane]);
    const float lam = expf(sa) - expf(sb) + LAM_INIT;
    float gsc[16];
#pragma unroll
    for (int i = 0; i < 16; ++i) gsc[i] = subg[(16 * F.lane + i) & 127] * (1.0f - LAM_INIT);
    for (int m = gw; m < MT; m += NGW) {
        const v4u* a = (const v4u*)(O1 + (size_t)m * DM + 16 * F.lane); const v4u* b = (const v4u*)(O2 + (size_t)m * DM + 16 * F.lane);
        const v4u a0 = a[0], a1 = a[1], b0 = b[0], b1 = b[1];
        float o[16]; float ss = 0.f;
#pragma unroll
        for (int i = 0; i < 8; ++i) { const unsigned wa = i < 4 ? a0[i & 3] : a1[i & 3], wb = i < 4 ? b0[i & 3] : b1[i & 3];
            o[2 * i] = __uint_as_float(wa << 16) - lam * __uint_as_float(wb << 16); o[2 * i + 1] = __uint_as_float(wa & 0xffff0000u) - lam * __uint_as_float(wb & 0xffff0000u);
            ss += o[2 * i] * o[2 * i] + o[2 * i + 1] * o[2 * i + 1]; }
        ss += __shfl_xor(ss, 1); ss += __shfl_xor(ss, 2); ss += __shfl_xor(ss, 4);
        const float rs = 1.f / sqrtf(ss * (1.f / 128.f) + LN_EPS);
        v4u w0, w1;
        w0.x = pk2(o[0] * rs * gsc[0], o[1] * rs * gsc[1]); w0.y = pk2(o[2] * rs * gsc[2], o[3] * rs * gsc[3]); w0.z = pk2(o[4] * rs * gsc[4], o[5] * rs * gsc[5]); w0.w = pk2(o[6] * rs * gsc[6], o[7] * rs * gsc[7]);
        w1.x = pk2(o[8] * rs * gsc[8], o[9] * rs * gsc[9]); w1.y = pk2(o[10] * rs * gsc[10], o[11] * rs * gsc[11]); w1.z = pk2(o[12] * rs * gsc[12], o[13] * rs * gsc[13]); w1.w = pk2(o[14] * rs * gsc[14], o[15] * rs * gsc[15]);
        v4u* d = (v4u*)(XN + (size_t)m * DM + 16 * F.lane); d[0] = w0; d[1] = w1;
    }
}
namespace samp {
constexpr float SAMPLE_SKIP_TH = 44.f;
using attn_body::bf16x8; using attn_body::f32x16; using attn_body::crow;
typedef float f32x4s __attribute__((ext_vector_type(4)));
__device__ __forceinline__ unsigned cvtpk(float lo, float hi) { return attn_body::cvtpk_s(lo, hi); }
__device__ __forceinline__ bf16x8 pack8(const f32x4s a, const f32x4s b) { attn_body::u32x4 w; w.x = cvtpk(a[0], a[1]); w.y = cvtpk(a[2], a[3]); w.z = cvtpk(b[0], b[1]); w.w = cvtpk(b[2], b[3]); return __builtin_bit_cast(bf16x8, w); }
#define SMFMA(a, b, c) __builtin_amdgcn_mfma_f32_32x32x16_bf16(a, b, c, 0, 0, 0)
template <int NDB>
__device__ __forceinline__ void softmax_upd(f32x16& p0, f32x16& p1, float& m, float& l, f32x16 (&o)[NDB]) {
    float rm = fmaxf(p0[0], p1[0]);
#pragma unroll
    for (int r = 1; r < 16; ++r) rm = fmaxf(rm, fmaxf(p0[r], p1[r]));
    rm = fmaxf(rm, __shfl_xor(rm, 32));
    const float mn = fmaxf(m, rm), al = __builtin_amdgcn_exp2f(m - mn); float sum = 0.f;
#pragma unroll
    for (int r = 0; r < 16; ++r) { p0[r] = __builtin_amdgcn_exp2f(p0[r] - mn); p1[r] = __builtin_amdgcn_exp2f(p1[r] - mn); sum += p0[r] + p1[r]; }
    l = l * al + sum; m = mn;
#pragma unroll
    for (int d = 0; d < NDB; ++d)
#pragma unroll
        for (int r = 0; r < 16; ++r) o[d][r] *= al;
}
__device__ __forceinline__ bf16x8 pfrag(const f32x16& p, int s) { attn_body::u32x4 w; w.x = cvtpk(p[8 * s], p[8 * s + 1]); w.y = cvtpk(p[8 * s + 2], p[8 * s + 3]); w.z = cvtpk(p[8 * s + 4], p[8 * s + 5]); w.w = cvtpk(p[8 * s + 6], p[8 * s + 7]); return __builtin_bit_cast(bf16x8, w); }

template <int MODE>
__device__ __forceinline__ void sample_unit(Frame& F, int u, const bf16* Qb, const bf16* Kb, const bf16* Vb, bf16* Ob1, bf16* Ob2, const float* cK, const float* cV, const float* Gs) {
    constexpr int DV = MODE == 0 ? 64 : 128, NDB = DV / 32;
    const int lane = F.lane, r32 = lane & 31, hi = lane >> 5, wid = F.wave;
    const int s = u >> 4; int kcol, vcol; float sl2 = 0.f; bf16* Ob = Ob1;
    if (MODE == 0) { const int h = u & 15; kcol = h * 64; vcol = h * 64; }
    else { const int head = (u >> 1) & 7, map = u & 1; kcol = head * 128 + map * 64; vcol = head * 128; sl2 = exp2f(-(float)(head + 1)) * LOG2E; Ob = map ? Ob2 : Ob1; }
    const size_t srow = (size_t)MP + 32 * s;
    bf16x8 qr[4];
#pragma unroll
    for (int d0 = 0; d0 < 4; ++d0) qr[d0] = *(const bf16x8*)(Qb + (srow + r32) * DM + kcol + d0 * 16 + hi * 8);
    float m = -1e30f, l = 0.f; f32x16 o[NDB];
#pragma unroll
    for (int d = 0; d < NDB; ++d) o[d] = f32x16{};
    const float* kbase = cK + (size_t)s * PAST * DM + kcol; const float* vbase = cV + (size_t)s * PAST * DM + vcol;
    const float* gs = Gs + (size_t)u * SKV;
    if (wid == 0) {
        f32x16 p0, p1;
#pragma unroll
        for (int r = 0; r < 16; ++r) p1[r] = -INFINITY;
#pragma unroll
        for (int g = 0; g < 4; ++g) {
            f32x4s b0 = {0.f, 0.f, 0.f, 0.f};
            if (MODE == 0) b0 = *(const f32x4s*)(gs + PAST + 8 * g + 4 * hi);
#pragma unroll
            for (int i = 0; i < 4; ++i) { const int kv = 8 * g + 4 * hi + i;
                if (MODE == 0) p0[4 * g + i] = kv > r32 ? -INFINITY : b0[i];
                else p0[4 * g + i] = sl2 * (float)(kv <= r32 ? kv : 2 * r32 - kv); }
        }
#pragma unroll
        for (int d0 = 0; d0 < 4; ++d0) { const bf16x8 ka = *(const bf16x8*)(Kb + (srow + r32) * DM + kcol + 16 * d0 + 8 * hi); p0 = SMFMA(ka, qr[d0], p0); }
        softmax_upd<NDB>(p0, p1, m, l, o);
#pragma unroll
        for (int ks = 0; ks < 2; ++ks) {
            const bf16x8 pb = pfrag(p0, ks);
            const bf16* vp = Vb + (srow + 16 * ks + 4 * hi) * DM + vcol + r32;
#pragma unroll
            for (int d = 0; d < NDB; ++d) {
                attn_body::u32x4 w;
#pragma unroll
                for (int jj = 0; jj < 4; ++jj) { const int j = 2 * jj; const unsigned lo = vp[(size_t)(8 * (j >> 2) + (j & 3)) * DM + 32 * d], hh = vp[(size_t)(8 * ((j + 1) >> 2) + ((j + 1) & 3)) * DM + 32 * d]; w[jj] = lo | (hh << 16); }
                o[d] = SMFMA(__builtin_bit_cast(bf16x8, w), pb, o[d]);
            }
        }
    }
#pragma unroll 1
    for (int T = PAST / 64 - 1 - wid; T >= 0; T -= NWAVES) {
        f32x16 p0, p1;
#pragma unroll
        for (int g = 0; g < 4; ++g) {
            if (MODE == 0) { const f32x4s b0 = *(const f32x4s*)(gs + 64 * T + 8 * g + 4 * hi), b1 = *(const f32x4s*)(gs + 64 * T + 32 + 8 * g + 4 * hi);
#pragma unroll
                for (int i = 0; i < 4; ++i) { p0[4 * g + i] = b0[i]; p1[4 * g + i] = b1[i]; } }
            else {
#pragma unroll
                for (int i = 0; i < 4; ++i) { const int kv = 64 * T + 8 * g + 4 * hi + i; p0[4 * g + i] = sl2 * (float)(kv - PAST); p1[4 * g + i] = sl2 * (float)(kv + 32 - PAST); } }
        }
#pragma unroll
        for (int d0 = 0; d0 < 4; ++d0) {
            const float* k0p = kbase + (size_t)(64 * T + r32) * DM + 16 * d0 + 8 * hi; const float* k1p = k0p + (size_t)32 * DM;
            const bf16x8 ka = pack8(*(const f32x4s*)k0p, *(const f32x4s*)(k0p + 4)), kb = pack8(*(const f32x4s*)k1p, *(const f32x4s*)(k1p + 4));
            p0 = SMFMA(ka, qr[d0], p0); p1 = SMFMA(kb, qr[d0], p1);
        }
        { float rm = fmaxf(p0[0], p1[0]);
#pragma unroll
          for (int r = 1; r < 16; ++r) rm = fmaxf(rm, fmaxf(p0[r], p1[r]));
          rm = fmaxf(rm, __shfl_xor(rm, 32));
          if (__all(rm < m - SAMPLE_SKIP_TH)) continue; }
        softmax_upd<NDB>(p0, p1, m, l, o);
#pragma unroll
        for (int hf = 0; hf < 2; ++hf)
#pragma unroll
            for (int ks = 0; ks < 2; ++ks) {
                const bf16x8 pb = pfrag(hf ? p1 : p0, ks);
                const float* vp = vbase + (size_t)(64 * T + 32 * hf + 16 * ks + 4 * hi) * DM + r32;
#pragma unroll
                for (int d = 0; d < NDB; ++d) {
                    f32x4s va, vb;
#pragma unroll
                    for (int j = 0; j < 4; ++j) { va[j] = vp[(size_t)j * DM + 32 * d]; vb[j] = vp[(size_t)(8 + j) * DM + 32 * d]; }
                    o[d] = SMFMA(pack8(va, vb), pb, o[d]);
                }
            }
    }
    l += __shfl_xor(l, 32);
    LAS float* ml = (LAS float*)F.lds;
    LAS float* ob = (LAS float*)(F.lds + 2048);
    if (hi == 0) { ml[(wid * 32 + r32) * 2] = m; ml[(wid * 32 + r32) * 2 + 1] = l; }
#pragma unroll
    for (int d = 0; d < NDB; ++d)
#pragma unroll
        for (int g = 0; g < 4; ++g) { f32x4s v = {o[d][4 * g], o[d][4 * g + 1], o[d][4 * g + 2], o[d][4 * g + 3]}; *(LAS f32x4s*)(ob + (size_t)(wid * 32 + r32) * DV + 32 * d + 8 * g + 4 * hi) = v; }
    __syncthreads();
    { constexpr int PER = DV / 16; const int q = F.tid >> 4, dg = F.tid & 15;
      float mw[NWAVES], M = -1e30f;
#pragma unroll
      for (int w = 0; w < NWAVES; ++w) { mw[w] = ml[(w * 32 + q) * 2]; M = fmaxf(M, mw[w]); }
      float L = 0.f, acc[PER];
#pragma unroll
      for (int i = 0; i < PER; ++i) acc[i] = 0.f;
#pragma unroll
      for (int w = 0; w < NWAVES; ++w) { const float wg = __builtin_amdgcn_exp2f(mw[w] - M); L += wg * ml[(w * 32 + q) * 2 + 1];
#pragma unroll
          for (int i = 0; i < PER; ++i) acc[i] += wg * ob[(size_t)(w * 32 + q) * DV + dg * PER + i]; }
      const float rl = 1.f / L;
      bf16* op = Ob + (srow + q) * DM + vcol + dg * PER;
#pragma unroll
      for (int i = 0; i < PER; i += 2) *(unsigned*)(op + i) = pk2(acc[i] * rl, acc[i + 1] * rl);
    }
    __syncthreads();
}
#undef SMFMA
}
constexpr float SKIP_TH = 44.f;
struct DiagPart { float mneg, qq; };
__device__ __forceinline__ DiagPart diag_part(Frame& F, const attn_body::bf16* Qc, const attn_body::bf16* Kc, long row0) {
    const int r32 = F.lane & 31, hi = F.lane >> 5;
    const attn_body::bf16* qp = Qc + (row0 + F.wave * 32 + r32) * DM + hi * 32; const attn_body::bf16* kp = Kc + (row0 + F.wave * 32 + r32) * DM + hi * 32;
    float d = 0.f, qq = 0.f;
#pragma unroll
    for (int c = 0; c < 4; ++c) { const bf16x8 qv = *(const bf16x8*)(qp + 8 * c), kv = *(const bf16x8*)(kp + 8 * c);
#pragma unroll
        for (int e = 0; e < 8; ++e) { const float qf = __uint_as_float((unsigned)(unsigned short)qv[e] << 16); d += qf * __uint_as_float((unsigned)(unsigned short)kv[e] << 16); qq += qf * qf; } }
    d += __shfl_xor(d, 32); qq += __shfl_xor(qq, 32);
    float mneg = fmaxf(0.f, -d);
#pragma unroll
    for (int o = 16; o >= 1; o >>= 1) { mneg = fmaxf(mneg, __shfl_xor(mneg, o)); qq = fmaxf(qq, __shfl_xor(qq, o)); }
    DiagPart r; r.mneg = mneg; r.qq = qq; return r;
}
__device__ __forceinline__ DiagPart diag_bound(Frame& F, volatile LAS int* qs, DiagPart p) {
    __syncthreads();
    if (F.lane == 0) { qs[8 + F.wave] = (int)__float_as_uint(p.mneg); qs[16 + F.wave] = (int)__float_as_uint(p.qq); }
    __syncthreads();
    float m = 0.f, q = 0.f;
#pragma unroll
    for (int w = 0; w < NWAVES; ++w) { m = fmaxf(m, __uint_as_float((unsigned)qs[8 + w])); q = fmaxf(q, __uint_as_float((unsigned)qs[16 + w])); }
    DiagPart r; r.mneg = m * 1.001f + 0.01f; r.qq = q * 1.0001f; return r;
}
template <int NC>
__device__ __forceinline__ void kv_out_block(Frame& F, const attn_body::bf16* src, float* dst) {
    constexpr int CPR = NC / 8, NI = NC / 16;
    v4u wv[NI];
#pragma unroll
    for (int i = 0; i < NI; ++i) { const int c = F.tid + i * NWAVES * 64; const int row = c / CPR, ch = c % CPR; wv[i] = *(const v4u*)(src + (size_t)row * DM + ch * 8); }
#pragma unroll
    for (int i = 0; i < NI; ++i) { const int c = F.tid + i * NWAVES * 64; const int row = c / CPR, ch = c % CPR; const v4u w = wv[i]; f32x4 a, b2;
        a[0] = __uint_as_float(w.x << 16); a[1] = __uint_as_float(w.x & 0xffff0000u); a[2] = __uint_as_float(w.y << 16); a[3] = __uint_as_float(w.y & 0xffff0000u);
        b2[0] = __uint_as_float(w.z << 16); b2[1] = __uint_as_float(w.z & 0xffff0000u); b2[2] = __uint_as_float(w.w << 16); b2[3] = __uint_as_float(w.w & 0xffff0000u);
        float* o = dst + (size_t)row * DM + ch * 8; __builtin_nontemporal_store(a, (f32x4*)o); __builtin_nontemporal_store(b2, (f32x4*)(o + 4)); }
}
template <int MODE>
__device__ __forceinline__ void attn_phase(Frame& F, unsigned char* lds_raw, const Args& A, unsigned char* ws, int qoff) {
    using abf = attn_body::bf16;
    constexpr int NVH = 32, NUNITS = 64 * NVH;
    LAS float* tab = (LAS float*)(F.lds + attn_body::LDS_TAB);
    gu32* ctr = F.ctl + CW_QUEUE + qoff;
    const unsigned* nb = (const unsigned*)(F.ctl + CW_NB + MODE * 128);
    if (threadIdx.x == 0) ((volatile LAS int*)(F.lds + LDSCTL_OFF))[0] = (int)__hip_atomic_fetch_add(ctr, 1u, __ATOMIC_RELAXED, __HIP_MEMORY_SCOPE_AGENT);
    for (;;) {
        F.tid = threadIdx.x; asm volatile("" : "+v"(F.tid)); F.lane = F.tid & 63; F.wave = __builtin_amdgcn_readfirstlane(F.tid >> 6);
        unsigned char* wl = ws; asm volatile("" : "+s"(wl));
        const abf* Qb = (const abf*)(wl + WS_Q); const abf* Kb = (const abf*)(wl + WS_K); const abf* Vb = (const abf*)(wl + WS_V);
        volatile LAS int* qs = (volatile LAS int*)(F.lds + LDSCTL_OFF) + (F.tid >> 20);
        __syncthreads();
        const int n = __builtin_amdgcn_readfirstlane(qs[0]);
        if (n >= NUNITS) break;
        const int qb = 63 - n / NVH, vhid = n % NVH, q0 = qb * 256;
        if (MODE == 0) {
            const int b = vhid >> 4, h = vhid & 15;
            const float* G = (const float*)(wl + WS_GP) + (size_t)vhid * SEQ;
            const float gq0 = G[q0]; const float gend = (F.tid < 4 * qb) ? G[64 * F.tid + 63] : 3.0e38f;
            const float bq2 = __uint_as_float(nb[(0 * 2 + b) * 32 + 2 * h]) + __uint_as_float(nb[(0 * 2 + b) * 32 + 2 * h + 1]);
            const float bk2 = __uint_as_float(nb[(1 * 2 + b) * 32 + 2 * h]) + __uint_as_float(nb[(1 * 2 + b) * 32 + 2 * h + 1]);
            const DiagPart dg = diag_bound(F, qs, diag_part(F, Qb + h * 64, Kb + h * 64, (long)b * SEQ + q0));
            const float thr = gq0 - 1.02f * sqrtf(fminf(bq2, dg.qq) * bk2) - dg.mneg - SKIP_TH;
            if (F.tid < 256) { const bool pred = gend < thr; const unsigned long long bm = __ballot(pred); if (F.lane == 0) qs[1 + F.wave] = __popcll(bm); }
            __syncthreads();
            const int t0 = __builtin_amdgcn_readfirstlane((qs[1] + qs[2] + qs[3] + qs[4]) & ~1);
            for (int i = 16 * t0 + F.tid; i < (q0 + 256) / 4; i += NWAVES * 64) *(LAS f32x4*)(tab + 4 * i) = *(const f32x4*)(G + 4 * i) - gq0;
            __syncthreads();
            attn_body::attn_unit<0, 24>((long)b * SEQ, qb, t0, Qb + h * 64, Kb + h * 64, Vb + h * 64, (abf*)(wl + WS_Q) + h * 64, (char*)lds_raw, 0.f);
            F.tid = threadIdx.x; asm volatile("" : "+v"(F.tid));
            int nn = 0; if (F.tid == 0) nn = (int)__hip_atomic_fetch_add(ctr, 1u, __ATOMIC_RELAXED, __HIP_MEMORY_SCOPE_AGENT);
            kv_out_block<64>(F, Kb + ((long)b * SEQ + q0) * DM + h * 64, A.out + O_FKP + ((size_t)b * SEQ + q0) * DM + h * 64);
            kv_out_block<64>(F, Vb + ((long)b * SEQ + q0) * DM + h * 64, A.out + O_FVP + ((size_t)b * SEQ + q0) * DM + h * 64);
            if (F.tid == 0) qs[0] = nn;
        } else {
            const int b = vhid >> 4, head = (vhid >> 1) & 7, map = vhid & 1;
            const float sl2 = exp2f(-(float)(head + 1)) * LOG2E;
            const int c32 = 4 * head + 2 * map;
            const DiagPart dg = diag_bound(F, qs, diag_part(F, Qb + head * 128 + map * 64, Kb + head * 128 + map * 64, (long)b * SEQ + q0));
            const float bq2 = __uint_as_float(nb[(0 * 2 + b) * 32 + c32]) + __uint_as_float(nb[(0 * 2 + b) * 32 + c32 + 1]);
            const float bk2 = __uint_as_float(nb[(1 * 2 + b) * 32 + c32]) + __uint_as_float(nb[(1 * 2 + b) * 32 + c32 + 1]);
            const float xlim = (float)(q0 - 63) - (1.02f * sqrtf(fminf(bq2, dg.qq) * bk2) + dg.mneg + SKIP_TH) / sl2;
            int t0 = xlim <= 0.f ? 0 : (int)(xlim * (1.f / 64.f));
            t0 = __builtin_amdgcn_readfirstlane(min(t0, 4 * qb) & ~1);
            const int qcol = head * 128 + map * 64, vcol = head * 128;
            attn_body::attn_unit_d128<24>((long)b * SEQ, qb, t0, Qb + qcol, Kb + qcol, Vb + vcol, (abf*)(wl + (map ? WS_O2 : WS_O1)) + vcol, (char*)lds_raw, 2.f * sl2);
            F.tid = threadIdx.x; asm volatile("" : "+v"(F.tid));
            int nn = 0; if (F.tid == 0) nn = (int)__hip_atomic_fetch_add(ctr, 1u, __ATOMIC_RELAXED, __HIP_MEMORY_SCOPE_AGENT);
            kv_out_block<64>(F, Kb + ((long)b * SEQ + q0) * DM + qcol, A.out + O_DKP + ((size_t)b * SEQ + q0) * DM + qcol);
            if (map == 0) kv_out_block<128>(F, Vb + ((long)b * SEQ + q0) * DM + vcol, A.out + O_DVP + ((size_t)b * SEQ + q0) * DM + vcol);
            if (F.tid == 0) qs[0] = nn;
        }
    }
    __syncthreads();
    F.tid = threadIdx.x; asm volatile("" : "+v"(F.tid)); F.lane = F.tid & 63; F.wave = __builtin_amdgcn_readfirstlane(F.tid >> 6);
    for (int u = F.vcu; u < 256; u += F.G) {
        if (MODE == 0) samp::sample_unit<0>(F, u, (const bf16*)(ws + WS_Q), (const bf16*)(ws + WS_K), (const bf16*)(ws + WS_V), (bf16*)(ws + WS_Q), (bf16*)(ws + WS_Q), A.in[2], A.in[3], (const float*)(ws + WS_GS));
        else samp::sample_unit<1>(F, u, (const bf16*)(ws + WS_Q), (const bf16*)(ws + WS_K), (const bf16*)(ws + WS_V), (bf16*)(ws + WS_O1), (bf16*)(ws + WS_O2), A.in[5], A.in[6], nullptr);
    }
}

#ifndef NPHASE
#define NPHASE 99
#endif
__global__ void __launch_bounds__(NWAVES * 64, 2) mk_fwd(Args args) {
    extern __shared__ __attribute__((aligned(16))) unsigned char lds[];
    Frame F;
    F.lds = (LAS unsigned char*)lds;
    F.MISC = (volatile LAS unsigned*)(F.lds + MISC_OFF);
    F.tid = threadIdx.x; F.lane = F.tid & 63; F.wave = __builtin_amdgcn_readfirstlane(F.tid >> 6);
    F.G = gridDim.x; { const int bx = blockIdx.x; F.vcu = (F.G % 8 == 0) ? (bx % 8) * (F.G / 8) + bx / 8 : bx; }
    unsigned char* ws = args.ws; const Args& A = args; float* out = args.out;
    F.ctl = (gu32*)(ws + WS_CTL);
    for (int u = F.tid; u < (LDS_BYTES - LDSCTL_OFF) / 4; u += NWAVES * 64) ((LAS unsigned*)(F.lds + LDSCTL_OFF))[u] = 0u;
    __syncthreads();
    XcdBarrier bar = xcd_barrier_post((unsigned*)(F.ctl + CW_BAR), F.MISC + 8);
#define GRID_BAR() do { xcd_barrier(bar); F.tid = threadIdx.x; asm volatile("" : "+v"(F.tid)); F.lane = F.tid & 63; F.wave = __builtin_amdgcn_readfirstlane(F.tid >> 6); } while (0)
    bf16* XN = (bf16*)(ws + WS_XN); bf16* QB = (bf16*)(ws + WS_Q); bf16* KB = (bf16*)(ws + WS_K); bf16* VB = (bf16*)(ws + WS_V); bf16* HB = (bf16*)(ws + WS_H);
    bf16* Y = (bf16*)(ws + WS_Y); float* YS = (float*)(ws + WS_X);

    p0_prologue(F, A, ws, out);
    GRID_BAR();
#if NPHASE >= 1
    p1_scan(F, A, ws, out);
    { pg8::Gemm g{XN, (const bf16*)(ws + WS_WFIN), MT, 3 * DM, DM}; pg8::StaticOrder S; S.init(MT, 3 * DM, F.G, (int)blockIdx.x, DM / 64);
      pg8::EpiQKV E{QB, (WS_K - WS_Q) / 2, out + O_FKP, out + O_FKS, attn_body::C2, (unsigned*)(F.ctl + CW_NB)};
      pg8::gemm_phase<pg8::EpiQKV, pg8::StaticOrder, true, true>(F.lds + RING_OFF, g, S, E); }
    p0_tail_items(F, A, ws, (MT / 256) * (3 * DM / 256) % F.G, TI_A, TI_B);
    GRID_BAR();
#endif
#if NPHASE >= 2
    attn_phase<0>(F, lds, A, ws, 0);
    GRID_BAR();
#endif
#if NPHASE >= 3
    { pg8::Gemm g{QB, (const bf16*)(ws + WS_WFOUT), MT, DM, DM}; pg8::SplitOrder S; S.init(MP, DM, F.G, (int)blockIdx.x, DM / 64, 4);
      pg8::EpiYSplit E{Y, YS, DM, 4};
      pg8::gemm_phase<pg8::EpiYSplit, pg8::SplitOrder, true, true>(F.lds + RING_OFF, g, S, E); }
    GRID_BAR();
    ln_phase<false, 4>(F, XN, Y, YS, A.in[16], A.in[17], nullptr, nullptr);
    GRID_BAR();
#endif
#if NPHASE >= 4
    { pg8::Gemm g{XN, (const bf16*)(ws + WS_WUP0), MT, 2 * DFF, DM}; pg8::StaticOrder S; S.init(MT, 2 * DFF, F.G, (int)blockIdx.x, DM / 64);
      pg8::EpiSwiGLU E{HB, DFF};
      pg8::gemm_phase<pg8::EpiSwiGLU, pg8::StaticOrder, true, true>(F.lds + RING_OFF, g, S, E); }
    GRID_BAR();
    { pg8::Gemm g{HB, (const bf16*)(ws + WS_WDN0), MT, DM, DFF}; pg8::SplitOrder S; S.init(MP, DM, F.G, (int)blockIdx.x, DFF / 64, 4);
      pg8::EpiYSplit E{Y, YS, DM, 4};
      pg8::gemm_phase<pg8::EpiYSplit, pg8::SplitOrder, true, true>(F.lds + RING_OFF, g, S, E); }
    GRID_BAR();
    ln_phase<false, 11>(F, XN, Y, YS, A.in[16] + DM, A.in[17] + DM, nullptr, nullptr);
    GRID_BAR();
#endif
#if NPHASE >= 5
    { pg8::Gemm g{XN, (const bf16*)(ws + WS_WDIN), MT, 3 * DM, DM}; pg8::StaticOrder S; S.init(MT, 3 * DM, F.G, (int)blockIdx.x, DM / 64);
      pg8::EpiQKV E{QB, (WS_K - WS_Q) / 2, out + O_DKP, out + O_DKS, attn_body::C2, (unsigned*)(F.ctl + CW_NB + 128)};
      pg8::gemm_phase<pg8::EpiQKV, pg8::StaticOrder, true, true>(F.lds + RING_OFF, g, S, E); }
    p0_tail_items(F, A, ws, (MT / 256) * (3 * DM / 256) % F.G, TI_B, TI_END);
    GRID_BAR();
#endif
#if NPHASE >= 6
    attn_phase<1>(F, lds, A, ws, 64);
    GRID_BAR();
    diff_combine(F, (const bf16*)(ws + WS_O1), (const bf16*)(ws + WS_O2), A.in[11], A.in[12], QB);
    GRID_BAR();
#endif
#if NPHASE >= 7
    { pg8::Gemm g{QB, (const bf16*)(ws + WS_WDOUT), MT, DM, DM}; pg8::SplitOrder S; S.init(MP, DM, F.G, (int)blockIdx.x, DM / 64, 4);
      pg8::EpiYSplit E{Y, YS, DM, 4};
      pg8::gemm_phase<pg8::EpiYSplit, pg8::SplitOrder, true, true>(F.lds + RING_OFF, g, S, E); }
    GRID_BAR();
    ln_phase<false, 4>(F, XN, Y, YS, A.in[16] + 2 * DM, A.in[17] + 2 * DM, nullptr, nullptr);
    GRID_BAR();
    { pg8::Gemm g{XN, (const bf16*)(ws + WS_WUP1), MT, 2 * DFF, DM}; pg8::StaticOrder S; S.init(MT, 2 * DFF, F.G, (int)blockIdx.x, DM / 64);
      pg8::EpiSwiGLU E{HB, DFF};
      pg8::gemm_phase<pg8::EpiSwiGLU, pg8::StaticOrder, true, true>(F.lds + RING_OFF, g, S, E); }
    GRID_BAR();
    { pg8::Gemm g{HB, (const bf16*)(ws + WS_WDN1), MT, DM, DFF}; pg8::SplitOrder S; S.init(MP, DM, F.G, (int)blockIdx.x, DFF / 64, 4);
      pg8::EpiYSplit E{Y, YS, DM, 4};
      pg8::gemm_phase<pg8::EpiYSplit, pg8::SplitOrder, true, true>(F.lds + RING_OFF, g, S, E); }
    GRID_BAR();
    ln_phase<true, 11>(F, XN, Y, YS, A.in[16] + 3 * DM, A.in[17] + 3 * DM, out + O_YP, out + O_YS);
#endif
}

extern "C" void kernel_launch(void* const* d_in, const int* in_sizes, int n_in, void* d_out, int out_size, void* d_ws, size_t ws_size, hipStream_t stream) {
    static int grid = 0;
    if (grid == 0) {
        if (n_in != 18 || (size_t)out_size != O_END || ws_size < WS_END) { fprintf(stderr, "kernel_launch: unexpected shapes (n_in %d out %d ws %zu); nothing launched\n", n_in, out_size, ws_size); grid = -1; return; }
        int dev = 0, cus = 0, per_cu = 0;
        if (hipGetDevice(&dev) != hipSuccess || hipDeviceGetAttribute(&cus, hipDeviceAttributeMultiprocessorCount, dev) != hipSuccess) { grid = -1; return; }
        if (hipFuncSetAttribute((const void*)mk_fwd, hipFuncAttributeMaxDynamicSharedMemorySize, LDS_BYTES) != hipSuccess) { fprintf(stderr, "kernel_launch: hipFuncSetAttribute failed\n"); grid = -1; return; }
        if (hipOccupancyMaxActiveBlocksPerMultiprocessor(&per_cu, (const void*)mk_fwd, NWAVES * 64, LDS_BYTES) != hipSuccess || per_cu < 1) { fprintf(stderr, "kernel_launch: occupancy query says %d blocks per CU\n", per_cu); }
        (void)hipGetLastError();
        grid = cus;
        if (grid != 256) { fprintf(stderr, "kernel_launch: built for 256 CUs, found %d; nothing launched\n", grid); grid = -1; return; }
    }
    if (grid < 0) return;
    if (hipMemsetAsync((char*)d_ws + WS_CTL, 0, CTL_ZERO_BYTES, stream) != hipSuccess) return;
    Args a{};
    for (int i = 0; i < 18; ++i) a.in[i] = (const float*)d_in[i];
    a.out = (float*)d_out; a.ws = (unsigned char*)d_ws;
    hipLaunchKernelGGL(mk_fwd, dim3(grid), dim3(NWAVES * 64), LDS_BYTES, stream, a);
}
```

```cpp
#include <hip/hip_runtime.h>
#include <cstdio>
#include <cstdint>
namespace pg8 {
#define PG8_LAS __attribute__((address_space(3)))
typedef unsigned short bf16_t;
typedef short bf16x8 __attribute__((ext_vector_type(8)));
typedef float f32x4 __attribute__((ext_vector_type(4)));
typedef unsigned u32x4 __attribute__((ext_vector_type(4)));
constexpr int BM = 256, BK = 64, HALF = 128, HTB = HALF * BK * 2  , STAGE_BYTES = 8 * HTB, NXCD = 8, WGM = 8;

__host__ __device__ __forceinline__ int lds_byte(int r, int c) { const int st = (r >> 4) * 2 + (c >> 5), rr = r & 15, cc = c & 31, ob = rr * 64 + cc * 2; return st * 1024 + (ob ^ (((ob >> 9) & 1) << 5)); }
__host__ __device__ __forceinline__ void stage_rc(int b, int& R, int& C) { const int st = b / 1024, sb = b % 1024, swz = sb ^ (((sb >> 9) & 1) << 5); R = (st >> 1) * 16 + swz / 64; C = (st & 1) * 32 + (swz % 64) / 2; }
__host__ __device__ __forceinline__ int perm32(int rho) { const int n = rho >> 4, i = rho & 15; return 8 * (i >> 2) + 4 * n + (i & 3); }

struct Unit { int pm, pn, kt0, nkt; };
struct Gemm { const bf16_t* A; const bf16_t* Bt; int M, N, K; };

struct StaticOrder {
    int nM, nN, nwg, G, c, nkt;
    __host__ __device__ void init(int M, int N, int G_, int c_, int nkt_) { nM = M / BM; nN = N / BM; nwg = nM * nN; G = G_; c = c_; nkt = nkt_; }
    __host__ __device__ bool next(int i, Unit& u) const {
        const long L = (long)i * G + c; if (L >= nwg) return false;
        int wgid = (int)L; { const int q = nwg / NXCD, r = nwg % NXCD, xcd = wgid % NXCD, off = wgid / NXCD; wgid = (xcd < r ? xcd * (q + 1) : r * (q + 1) + (xcd - r) * q) + off; }
        const int nig = WGM * nN, gid = wgid / nig, fm = gid * WGM, gsz = (nM - fm) < WGM ? (nM - fm) : WGM;
        u.pm = fm + ((wgid % nig) % gsz); u.pn = (wgid % nig) / gsz; u.kt0 = 0; u.nkt = nkt; return true;
    }
    __device__ __forceinline__ void a_ready(const Unit&) const {}
    __device__ __forceinline__ void done(const Unit&) const {}
};
struct SplitOrder {
    StaticOrder P; int nP, nN, nSl, KS, G, c;
    __host__ __device__ void init(int Mp, int N, int G_, int c_, int nkt_full, int KS_) { P.init(Mp, N, G_, c_, nkt_full); nP = P.nwg; nN = N / BM; KS = KS_; nSl = nkt_full / KS_; G = G_; c = c_; }
    __host__ __device__ bool next(int i, Unit& u) const {
        const long L = (long)i * G + c;
        if (L < nP) return P.next(i, u);
        const int j = (int)(L - nP); if (j >= 2 * nN * nSl) return false;
        u.pm = 128 + (j & 1); const int r = j >> 1; u.pn = r % nN; u.kt0 = (r / nN) * KS; u.nkt = KS; return true;
    }
    __device__ __forceinline__ void a_ready(const Unit&) const {}
    __device__ __forceinline__ void done(const Unit&) const {}
};
__device__ __forceinline__ unsigned cvt_pk_bf16(float lo, float hi) { unsigned r; asm volatile("v_cvt_pk_bf16_f32 %0, %1, %2" : "=v"(r) : "v"(lo), "v"(hi)); return r; }
typedef float f32x2 __attribute__((ext_vector_type(2)));
struct EpiQKV {
    static constexpr bool PERM = true, AFTER_DRAIN = false;
    bf16_t* Q; size_t qkv_stride; float* okp; float* oks; float qscale; unsigned* nb;
    __device__ __forceinline__ void operator()(const f32x4 (&acc)[2][2][4][2], const Unit& u, int wr, int wc, int fr, int fq) const {
        const int t = u.pn >> 2, colt = (u.pn & 3) * BM; const bool samp = u.pm >= 128;
        bf16_t* base = Q + (size_t)t * qkv_stride;
        float* fbase = samp ? oks + (size_t)(t == 2 ? 512 * 1024 : 0) - (size_t)32768 * 1024 : okp + (size_t)(t == 2 ? 32768 * 1024 : 0);
        const float sc = t == 0 ? qscale : 1.f;
        const int row0 = u.pm * BM + wr * 64 + fr, col0 = colt + wc * 32 + 8 * fq;
        float mx0 = 0.f, mx1 = 0.f;
#pragma unroll
        for (int ai = 0; ai < 2; ++ai)
#pragma unroll
            for (int m = 0; m < 4; ++m) { const int row = row0 + ai * HALF + m * 16;
#pragma unroll
                for (int bj = 0; bj < 2; ++bj) { const f32x4 v0 = acc[ai][bj][m][0] * sc, v1 = acc[ai][bj][m][1] * sc;
                    u32x4 w; w.x = cvt_pk_bf16(v0[0], v0[1]); w.y = cvt_pk_bf16(v0[2], v0[3]); w.z = cvt_pk_bf16(v1[0], v1[1]); w.w = cvt_pk_bf16(v1[2], v1[3]);
                    *(u32x4*)(base + (size_t)row * 1024 + col0 + bj * HALF) = w;
                    if (t != 0 && samp) { float* fp = fbase + (size_t)row * 1024 + col0 + bj * HALF; __builtin_nontemporal_store(v0, (f32x4*)fp); __builtin_nontemporal_store(v1, (f32x4*)(fp + 4)); }
                    if (t != 2 && !samp) { float s = (v0[0] * v0[0] + v0[1] * v0[1]) + (v0[2] * v0[2] + v0[3] * v0[3]) + (v1[0] * v1[0] + v1[1] * v1[1]) + (v1[2] * v1[2] + v1[3] * v1[3]);
                        s += __shfl_xor(s, 16); s += __shfl_xor(s, 32); if (bj == 0) mx0 = fmaxf(mx0, s); else mx1 = fmaxf(mx1, s); } } }
        if (t != 2 && !samp) {
#pragma unroll
            for (int o = 1; o < 16; o <<= 1) { mx0 = fmaxf(mx0, __shfl_xor(mx0, o)); mx1 = fmaxf(mx1, __shfl_xor(mx1, o)); }
            if ((fr | fq) == 0) { unsigned* p = nb + (t * 2 + (u.pm >> 6)) * 32 + (colt + wc * 32) / 32;
                __hip_atomic_fetch_max(p, __float_as_uint(mx0), __ATOMIC_RELAXED, __HIP_MEMORY_SCOPE_AGENT); __hip_atomic_fetch_max(p + 4, __float_as_uint(mx1), __ATOMIC_RELAXED, __HIP_MEMORY_SCOPE_AGENT); }
        }
    }
};
struct EpiBf16 {
    static constexpr bool PERM = true, AFTER_DRAIN = false;
    bf16_t* Y; int ldc;
    __device__ __forceinline__ void operator()(const f32x4 (&acc)[2][2][4][2], const Unit& u, int wr, int wc, int fr, int fq) const {
        const int row0 = u.pm * BM + wr * 64 + fr, col0 = u.pn * BM + wc * 32 + 8 * fq;
#pragma unroll
        for (int ai = 0; ai < 2; ++ai)
#pragma unroll
            for (int m = 0; m < 4; ++m) { bf16_t* rp = Y + (size_t)(row0 + ai * HALF + m * 16) * ldc + col0;
#pragma unroll
                for (int bj = 0; bj < 2; ++bj) { const f32x4 v0 = acc[ai][bj][m][0], v1 = acc[ai][bj][m][1];
                    u32x4 w; w.x = cvt_pk_bf16(v0[0], v0[1]); w.y = cvt_pk_bf16(v0[2], v0[3]); w.z = cvt_pk_bf16(v1[0], v1[1]); w.w = cvt_pk_bf16(v1[2], v1[3]);
                    *(u32x4*)(rp + bj * HALF) = w; } }
    }
};
struct EpiYSplit {
    static constexpr bool PERM = true, AFTER_DRAIN = false;
    bf16_t* Y; float* slab; int ldc, KS;
    __device__ __forceinline__ void operator()(const f32x4 (&acc)[2][2][4][2], const Unit& u, int wr, int wc, int fr, int fq) const {
        const int row0 = u.pm * BM + wr * 64 + fr, col0 = u.pn * BM + wc * 32 + 8 * fq;
        if (u.pm < 128) {
#pragma unroll
            for (int ai = 0; ai < 2; ++ai)
#pragma unroll
                for (int m = 0; m < 4; ++m) { bf16_t* rp = Y + (size_t)(row0 + ai * HALF + m * 16) * ldc + col0;
#pragma unroll
                    for (int bj = 0; bj < 2; ++bj) { const f32x4 v0 = acc[ai][bj][m][0], v1 = acc[ai][bj][m][1];
                        u32x4 w; w.x = cvt_pk_bf16(v0[0], v0[1]); w.y = cvt_pk_bf16(v0[2], v0[3]); w.z = cvt_pk_bf16(v1[0], v1[1]); w.w = cvt_pk_bf16(v1[2], v1[3]);
                        *(u32x4*)(rp + bj * HALF) = w; } }
        } else {
            float* sb = slab + (size_t)(u.kt0 / KS) * 512 * ldc - (size_t)32768 * ldc;
#pragma unroll
            for (int ai = 0; ai < 2; ++ai)
#pragma unroll
                for (int m = 0; m < 4; ++m) { float* rp = sb + (size_t)(row0 + ai * HALF + m * 16) * ldc + col0;
#pragma unroll
                    for (int bj = 0; bj < 2; ++bj) { *(f32x4*)(rp + bj * HALF) = acc[ai][bj][m][0]; *(f32x4*)(rp + bj * HALF + 4) = acc[ai][bj][m][1]; } }
        }
    }
};
struct EpiSwiGLU {
    static constexpr bool PERM = true, AFTER_DRAIN = false;
    bf16_t* H; int ldc;
    __device__ __forceinline__ void operator()(const f32x4 (&acc)[2][2][4][2], const Unit& u, int wr, int wc, int fr, int fq) const {
        const int row0 = u.pm * BM + wr * 64 + fr, col0 = u.pn * HALF + wc * 32 + 8 * fq;
#pragma unroll
        for (int ai = 0; ai < 2; ++ai)
#pragma unroll
            for (int m = 0; m < 4; ++m) { float r[8];
#pragma unroll
                for (int n = 0; n < 2; ++n)
#pragma unroll
                    for (int i = 0; i < 4; ++i) { const float g = acc[ai][0][m][n][i], uu = acc[ai][1][m][n][i];
                        r[4 * n + i] = g * uu * __builtin_amdgcn_rcpf(1.0f + __builtin_amdgcn_exp2f(-1.4426950408889634f * g)); }
                u32x4 w; w.x = cvt_pk_bf16(r[0], r[1]); w.y = cvt_pk_bf16(r[2], r[3]); w.z = cvt_pk_bf16(r[4], r[5]); w.w = cvt_pk_bf16(r[6], r[7]);
                *(u32x4*)(H + (size_t)(row0 + ai * HALF + m * 16) * ldc + col0) = w; }
    }
};
template <class Epi, class Sched, bool ALIGN_EPI = false, bool SP2 = false>
__device__ __forceinline__ void gemm_phase(PG8_LAS unsigned char* lds, const Gemm g, const Sched& S, const Epi& E) {
    int tid_ = threadIdx.x; asm volatile("" : "+v"(tid_));
    const int tid = tid_, wid = __builtin_amdgcn_readfirstlane(tid >> 6), lane = tid & 63, wr = wid >> 2, wc = wid & 3, fr = lane & 15, fq = lane >> 4;
    const int K = g.K;
    unsigned voffA[2], voffB[2];
#pragma unroll
    for (int i = 0; i < 2; ++i) { int R, C; stage_rc(tid * 16 + i * 8192, R, C); const int Rb = Epi::PERM ? ((R & ~31) + perm32(R & 31)) : R;
        voffA[i] = (unsigned)(R * K + C) * 2u; voffB[i] = (unsigned)(Rb * K + C) * 2u; }
    const size_t kstep = (size_t)(BK * 2);
    const size_t hstep = (size_t)HALF * K * 2;
    const size_t tstep = 2 * hstep;
    const unsigned ldsw = (unsigned)wid * 1024u;
    const int aoff = lds_byte(wr * 64 + fr, fq * 8), boff = lds_byte(wc * 32 + fr, fq * 8);
#define PG8_SA(b, h) (((b) * 2 + (h)) * HTB)
#define PG8_SB(b, h) ((4 + (b) * 2 + (h)) * HTB)
#define PG8_STAGE(bufoff, gbase, voff) do { _Pragma("unroll") for (int _i = 0; _i < 2; ++_i) \
        __builtin_amdgcn_global_load_lds((const unsigned*)((const char*)(gbase) + (voff)[_i]), (PG8_LAS unsigned*)(lds + (bufoff) + ldsw + _i * 8192), 16, 0, 0); } while (0)
#define PG8_LDA(dst, b, h) do { _Pragma("unroll") for (int m = 0; m < 4; ++m) _Pragma("unroll") for (int k = 0; k < 2; ++k) dst[m][k] = *(const PG8_LAS bf16x8*)(lds + PG8_SA(b, h) + aoff + m * 2048 + k * 1024); } while (0)
#define PG8_LDB(dst, b, h) do { _Pragma("unroll") for (int n = 0; n < 2; ++n) _Pragma("unroll") for (int k = 0; k < 2; ++k) dst[n][k] = *(const PG8_LAS bf16x8*)(lds + PG8_SB(b, h) + boff + n * 2048 + k * 1024); } while (0)
#define PG8_MMA(ai, bj, At, Bt) do { __builtin_amdgcn_s_setprio(1); _Pragma("unroll") for (int m = 0; m < 4; ++m) _Pragma("unroll") for (int n = 0; n < 2; ++n) _Pragma("unroll") for (int k = 0; k < 2; ++k) \
        acc[ai][bj][m][n] = __builtin_amdgcn_mfma_f32_16x16x32_bf16(Bt[n][k], At[m][k], acc[ai][bj][m][n], 0, 0, 0); __builtin_amdgcn_s_setprio(0); } while (0)
#define PG8_WAIT_V(n) asm volatile("s_waitcnt vmcnt(" #n ")" ::: "memory")
#define PG8_WAIT_L(n) asm volatile("s_waitcnt lgkmcnt(" #n ")" ::: "memory")
#define PG8_BAR __builtin_amdgcn_s_barrier()
#define PG8_SCHED __builtin_amdgcn_sched_barrier(0)
    Unit cur, nxt; int ui = 0;
    if (!S.next(0, cur)) return;
    f32x4 acc[2][2][4][2];
#pragma unroll
    for (int a = 0; a < 2; ++a)
#pragma unroll
        for (int b = 0; b < 2; ++b)
#pragma unroll
            for (int m = 0; m < 4; ++m)
#pragma unroll
                for (int n = 0; n < 2; ++n) acc[a][b][m][n] = (f32x4){0.f, 0.f, 0.f, 0.f};
    bf16x8 At[4][2], B0[2][2], B1[2][2];
    const char* cA = (const char*)g.A + (size_t)cur.pm * tstep + (size_t)cur.kt0 * kstep; const char* cB = (const char*)g.Bt + (size_t)cur.pn * tstep + (size_t)cur.kt0 * kstep;
    S.a_ready(cur);
    if constexpr (SP2) {
        PG8_STAGE(PG8_SB(0, 0), cB, voffB); PG8_STAGE(PG8_SB(0, 1), cB + hstep, voffB); PG8_STAGE(PG8_SA(0, 0), cA, voffA); PG8_STAGE(PG8_SA(0, 1), cA + hstep, voffA);
        if (wr == 1) PG8_BAR;
        PG8_WAIT_V(2); PG8_BAR;
        PG8_STAGE(PG8_SB(1, 0), cB + kstep, voffB); PG8_STAGE(PG8_SA(1, 0), cA + kstep, voffA); PG8_STAGE(PG8_SB(1, 1), cB + hstep + kstep, voffB);
        PG8_WAIT_V(6); PG8_BAR;
    } else {
        PG8_STAGE(PG8_SB(0, 0), cB, voffB); PG8_STAGE(PG8_SA(0, 0), cA, voffA); PG8_STAGE(PG8_SB(0, 1), cB + hstep, voffB); PG8_STAGE(PG8_SA(0, 1), cA + hstep, voffA);
        if (wr == 1) PG8_BAR;
        PG8_WAIT_V(4); PG8_BAR;
        PG8_STAGE(PG8_SB(1, 0), cB + kstep, voffB); PG8_STAGE(PG8_SA(1, 0), cA + kstep, voffA); PG8_STAGE(PG8_SB(1, 1), cB + hstep + kstep, voffB);
        PG8_WAIT_V(6); PG8_BAR;
    }
    for (;;) {
        const bool has_next = S.next(ui + 1, nxt);
        const char* nA = has_next ? (const char*)g.A + (size_t)nxt.pm * tstep + (size_t)nxt.kt0 * kstep : cA; const char* nB = has_next ? (const char*)g.Bt + (size_t)nxt.pn * tstep + (size_t)nxt.kt0 * kstep : cB;
        const int nt = cur.nkt;
        for (int t = 0; t < nt; t += 2) {
            const bool last = (t == nt - 2);
            const char* a1 = cA + (size_t)(t + 1) * kstep;
            const char* a2 = last ? nA : cA + (size_t)(t + 2) * kstep; const char* b2 = last ? nB : cB + (size_t)(t + 2) * kstep;
            const char* a3 = a2 + kstep; const char* b3 = b2 + kstep;
            if (last && has_next) S.a_ready(nxt);
            if constexpr (SP2) {
            PG8_LDB(B0, 0, 0); PG8_LDB(B1, 0, 1); PG8_SCHED; PG8_LDA(At, 0, 0); PG8_STAGE(PG8_SA(1, 1), a1 + hstep, voffA);
            PG8_WAIT_V(8); PG8_WAIT_L(0); PG8_BAR; PG8_MMA(0, 0, At, B0); PG8_MMA(0, 1, At, B1); PG8_BAR; PG8_SCHED;
            PG8_LDA(At, 0, 1); PG8_STAGE(PG8_SB(0, 0), b2, voffB); PG8_STAGE(PG8_SB(0, 1), b2 + hstep, voffB); PG8_STAGE(PG8_SA(0, 0), a2, voffA);
            PG8_WAIT_V(8); PG8_WAIT_L(0); PG8_BAR; PG8_MMA(1, 0, At, B0); PG8_MMA(1, 1, At, B1); PG8_BAR; PG8_SCHED;
            PG8_LDB(B0, 1, 0); PG8_LDB(B1, 1, 1); PG8_SCHED; PG8_LDA(At, 1, 0); PG8_STAGE(PG8_SA(0, 1), a2 + hstep, voffA);
            PG8_WAIT_V(8); PG8_WAIT_L(0); PG8_BAR; PG8_MMA(0, 0, At, B0); PG8_MMA(0, 1, At, B1); PG8_BAR; PG8_SCHED;
            PG8_LDA(At, 1, 1); PG8_STAGE(PG8_SB(1, 0), b3, voffB); PG8_STAGE(PG8_SB(1, 1), b3 + hstep, voffB); PG8_STAGE(PG8_SA(1, 0), a3, voffA);
            PG8_WAIT_V(8); PG8_WAIT_L(0); PG8_BAR; PG8_MMA(1, 0, At, B0); PG8_MMA(1, 1, At, B1); PG8_BAR; PG8_SCHED;
            } else {
            PG8_LDB(B0, 0, 0); PG8_SCHED; PG8_LDA(At, 0, 0); PG8_STAGE(PG8_SA(1, 1), a1 + hstep, voffA);
            PG8_WAIT_L(8); PG8_BAR; PG8_WAIT_L(0); PG8_MMA(0, 0, At, B0); PG8_BAR; PG8_SCHED;
            PG8_LDB(B1, 0, 1); PG8_STAGE(PG8_SB(0, 0), b2, voffB);
            PG8_BAR; PG8_WAIT_L(0); PG8_MMA(0, 1, At, B1); PG8_BAR;
            PG8_LDA(At, 0, 1); PG8_STAGE(PG8_SA(0, 0), a2, voffA);
            PG8_BAR; PG8_WAIT_L(0); PG8_MMA(1, 0, At, B0); PG8_BAR; PG8_SCHED;
            PG8_STAGE(PG8_SB(0, 1), b2 + hstep, voffB);
            PG8_WAIT_V(6); PG8_BAR; PG8_MMA(1, 1, At, B1); PG8_BAR;
            PG8_LDB(B0, 1, 0); PG8_SCHED; PG8_LDA(At, 1, 0); PG8_STAGE(PG8_SA(0, 1), a2 + hstep, voffA);
            PG8_WAIT_L(8); PG8_BAR; PG8_WAIT_L(0); PG8_MMA(0, 0, At, B0); PG8_BAR; PG8_SCHED;
            PG8_LDB(B1, 1, 1); PG8_STAGE(PG8_SB(1, 0), b3, voffB);
            PG8_BAR; PG8_WAIT_L(0); PG8_MMA(0, 1, At, B1); PG8_BAR;
            PG8_LDA(At, 1, 1); PG8_STAGE(PG8_SA(1, 0), a3, voffA);
            PG8_BAR; PG8_WAIT_L(0); PG8_MMA(1, 0, At, B0); PG8_BAR; PG8_SCHED;
            PG8_STAGE(PG8_SB(1, 1), b3 + hstep, voffB);
            PG8_WAIT_V(6); PG8_BAR; PG8_MMA(1, 1, At, B1); PG8_BAR;
            }
        }
        if constexpr (ALIGN_EPI) { if (wr == 0) PG8_BAR; }
        if constexpr (!Epi::AFTER_DRAIN) { E(acc, cur, wr, wc, fr, fq); S.done(cur); }
        if (!has_next) break;
#pragma unroll
        for (int a = 0; a < 2; ++a)
#pragma unroll
            for (int b = 0; b < 2; ++b)
#pragma unroll
                for (int m = 0; m < 4; ++m)
#pragma unroll
                    for (int n = 0; n < 2; ++n) acc[a][b][m][n] = (f32x4){0.f, 0.f, 0.f, 0.f};
        cur = nxt; cA = nA; cB = nB; ++ui;
        if constexpr (ALIGN_EPI) { if (wr == 1) PG8_BAR; }
    }
    PG8_WAIT_V(0);
    if constexpr (!ALIGN_EPI) { if (wr == 0) PG8_BAR; }
    PG8_BAR;
    if constexpr (Epi::AFTER_DRAIN) { E.fused(acc, cur, wr, wc, fr, fq, lds, wid, lane); S.done(cur); }
#undef PG8_SA
#undef PG8_SB
#undef PG8_STAGE
#undef PG8_LDA
#undef PG8_LDB
#undef PG8_MMA
#undef PG8_WAIT_V
#undef PG8_WAIT_L
#undef PG8_BAR
#undef PG8_SCHED
}
}

#ifndef PG8_SP2
#define PG8_SP2 true
#endif
#ifndef PG8_ALIGN
#define PG8_ALIGN true
#endif
#include <hip/hip_bf16.h>
#include <cmath>
namespace attn_body {
using bf16=__hip_bfloat16;
using bf16x8=__attribute__((ext_vector_type(8)))short;
using s16x4=__attribute__((ext_vector_type(4)))short;
using f32x16=__attribute__((ext_vector_type(16)))float;
using u32x4=__attribute__((ext_vector_type(4)))unsigned;
constexpr int BATCH=2,NHEAD=16,SEQ=16384,D=64,DM=NHEAD*D;
constexpr int NW=8,QBLK=32,QB=QBLK*NW,KVBLK=64,NQB=SEQ/QB;
constexpr int ATTN_PITCH=DM, ATTN_UNIT_ROWS=QB;
__device__ __forceinline__ int crow(int r,int hi){return (r&3)+8*(r>>2)+4*hi;}
#define SBAR() __builtin_amdgcn_sched_barrier(0)
__device__ __forceinline__ void cmask(f32x16&p0,f32x16&p1,int jb,int qrel,int hi){
  const float NEG=-INFINITY; int kb=64*jb+4*hi;
  #pragma unroll
  for(int r=0;r<16;++r){int kv=kb+(r&3)+8*(r>>2); if(kv>qrel)p0[r]=NEG; if(kv+32>qrel)p1[r]=NEG;}
}

__device__ __forceinline__ void dmask(f32x16&p0,f32x16&p1,int jb,int qrel,int hi,float s2){
  const float NEG=-INFINITY; const int c=qrel>>6; const int kb=64*jb+4*hi;
  if(jb>c){
    #pragma unroll
    for(int r=0;r<16;++r){p0[r]=NEG;p1[r]=NEG;}
  } else if(jb==c){
    #pragma unroll
    for(int r=0;r<16;++r){const int kv=kb+(r&3)+8*(r>>2); if(kv>qrel)p0[r]+=s2*(float)(qrel-kv); if(kv+32>qrel)p1[r]+=s2*(float)(qrel-kv-32);}
  }
}
typedef float f32x4_t __attribute__((ext_vector_type(4)));
constexpr int NSLOT=3, SLOTB=8192;
constexpr int LDS_K=0, LDS_V=NSLOT*SLOTB, LDS_WS=2*NSLOT*SLOTB, LDS_OST=LDS_WS+NW*64*4, LDS_TAB=LDS_OST+NW*4096, LDS_BYTES=LDS_TAB+SEQ*4;
constexpr float C2=0.125f*1.4426950408889634f;
__device__ __forceinline__ void glds16(const void*gsrc,unsigned lds_dst){unsigned keep;
  asm volatile("s_mov_b32 %0, m0\n\ts_mov_b32 m0, %2\n\ts_nop 0\n\tglobal_load_lds_dwordx4 %1, off\n\ts_mov_b32 m0, %0":"=&s"(keep):"v"(gsrc),"s"(lds_dst):"memory");}
__device__ __forceinline__ void glds16sf(const void*sbase,unsigned voff,unsigned lds_dst){unsigned keep;
  asm volatile("s_mov_b32 %0, m0\n\ts_mov_b32 m0, %3\n\ts_nop 0\n\tglobal_load_lds_dwordx4 %1, %2\n\ts_mov_b32 m0, %0":"=&s"(keep):"v"(voff),"s"(sbase),"s"(lds_dst):"memory");}
__device__ __forceinline__ float max3f(float a,float b,float c){float r;asm("v_max3_f32 %0, %1, %2, %3":"=v"(r):"v"(a),"v"(b),"v"(c));return r;}
__device__ __forceinline__ float max2f(float a,float b){float r;asm("v_max_f32_e32 %0, %1, %2":"=v"(r):"v"(a),"v"(b));return r;}
__device__ __forceinline__ float fadd_s(float a,float b){float r;asm("v_add_f32_e32 %0, %1, %2":"=v"(r):"v"(a),"v"(b));return r;}
__device__ __forceinline__ float fsub_s(float a,float b){float r;asm("v_sub_f32_e32 %0, %1, %2":"=v"(r):"v"(a),"v"(b));return r;}
typedef float f32x2_t __attribute__((ext_vector_type(2))); typedef __bf16 bf16x2_t __attribute__((ext_vector_type(2)));
__device__ __forceinline__ unsigned cvtpk_s(float lo,float hi){f32x2_t v={lo,hi};bf16x2_t b=__builtin_convertvector(v,bf16x2_t);return __builtin_bit_cast(unsigned,b);}
#define WAIT_BAR(N) asm volatile("s_waitcnt vmcnt(" #N ") lgkmcnt(0)\n\ts_barrier":::"memory")

__device__ __forceinline__ void qkt(f32x16&p0,f32x16&p1,const char*Kslot,const bf16x8*qr,int r32,int hi){
  const char*kb=Kslot+hi*1024+r32*16;
  #pragma unroll
  for(int d0=0;d0<4;++d0){
    const bf16x8 b0=*reinterpret_cast<const bf16x8*>(kb+d0*2048);
    const bf16x8 b1=*reinterpret_cast<const bf16x8*>(kb+d0*2048+512);
    {p0=__builtin_amdgcn_mfma_f32_32x32x16_bf16(b0,qr[d0],p0,0,0,0);p1=__builtin_amdgcn_mfma_f32_32x32x16_bf16(b1,qr[d0],p1,0,0,0);}}
}
typedef __attribute__((address_space(3))) const char* lds_cptr;
typedef short v4i16_t __attribute__((ext_vector_type(4)));
__device__ __forceinline__ void kload8(bf16x8*kf,lds_cptr kp){
  kf[0]=*(const __attribute__((address_space(3))) bf16x8*)(kp);      kf[1]=*(const __attribute__((address_space(3))) bf16x8*)(kp+512);
  kf[2]=*(const __attribute__((address_space(3))) bf16x8*)(kp+2048); kf[3]=*(const __attribute__((address_space(3))) bf16x8*)(kp+2560);
  kf[4]=*(const __attribute__((address_space(3))) bf16x8*)(kp+4096); kf[5]=*(const __attribute__((address_space(3))) bf16x8*)(kp+4608);
  kf[6]=*(const __attribute__((address_space(3))) bf16x8*)(kp+6144); kf[7]=*(const __attribute__((address_space(3))) bf16x8*)(kp+6656);
}
__device__ __forceinline__ void kload2(bf16x8*kf,lds_cptr kp,int j){ kf[2*j]=*(const __attribute__((address_space(3))) bf16x8*)(kp+j*2048); kf[2*j+1]=*(const __attribute__((address_space(3))) bf16x8*)(kp+j*2048+512); }
__device__ __forceinline__ s16x4 vtr(lds_cptr p){ return __builtin_bit_cast(s16x4,__builtin_amdgcn_ds_read_tr16_b64_v4i16((__attribute__((address_space(3))) v4i16_t*)p)); }
__device__ __forceinline__ float rowmax(const f32x16&p0,const f32x16&p1){
  float a=max3f(p0[0],p0[1],p1[0]),b=max3f(p0[2],p0[3],p1[1]);a=max3f(a,p1[2],p1[3]);
  #pragma unroll
  for(int r=4;r<16;r+=4){a=max3f(a,p0[r],p0[r+1]);b=max3f(b,p0[r+2],p0[r+3]);a=max3f(a,p1[r],p1[r+1]);b=max3f(b,p1[r+2],p1[r+3]);}
  const float m=max2f(a,b);
  auto rr=__builtin_amdgcn_permlane32_swap(__float_as_uint(m),__float_as_uint(m),false,false);
  return max2f(__uint_as_float(rr[0]),__uint_as_float(rr[1]));
}
__device__ __forceinline__ void pv(f32x16*o,int vb,bf16x8 pa0,bf16x8 pa1,bf16x8 pa2,bf16x8 pa3){
  #pragma unroll
  for(int d0=0;d0<2;++d0){s16x4 lo[4],hi[4];
    #pragma unroll
    for(int ks=0;ks<4;++ks){
      asm volatile("ds_read_b64_tr_b16 %0,%1 offset:%c2":"=&v"(lo[ks]):"v"(vb),"i"(d0*4096+ks*1024):"memory");
      asm volatile("ds_read_b64_tr_b16 %0,%1 offset:%c2":"=&v"(hi[ks]):"v"(vb),"i"(d0*4096+ks*1024+512):"memory");}
    asm volatile("s_waitcnt lgkmcnt(0)":::"memory");SBAR();
    #define PK(k) (bf16x8){lo[k][0],lo[k][1],lo[k][2],lo[k][3],hi[k][0],hi[k][1],hi[k][2],hi[k][3]}
    o[d0]=__builtin_amdgcn_mfma_f32_32x32x16_bf16(pa0,PK(0),o[d0],0,0,0);
    o[d0]=__builtin_amdgcn_mfma_f32_32x32x16_bf16(pa1,PK(1),o[d0],0,0,0);
    o[d0]=__builtin_amdgcn_mfma_f32_32x32x16_bf16(pa2,PK(2),o[d0],0,0,0);
    o[d0]=__builtin_amdgcn_mfma_f32_32x32x16_bf16(pa3,PK(3),o[d0],0,0,0);
    #undef PK
  }
}

#ifndef ATTN_STORE16
#define ATTN_STORE16(p,v) (*(u32x4*)(p)=(v))
#endif
template<int MODE,int THRL> __device__ __forceinline__ void attn_unit(long rowbase,int qb,int t0,const bf16*Q,const bf16*__restrict__ K,const bf16*__restrict__ V,bf16*O,char*shm,float s2){
  int tid_=threadIdx.x; asm volatile("":"+v"(tid_)); const int tid=tid_,lane=tid&63,r32=lane&31,hi=lane>>5; const int wid=__builtin_amdgcn_readfirstlane(tid>>6);
  const int q0=qb*QB;
  const bf16*Qw=Q+(rowbase+q0+wid*QBLK)*DM;
  const bf16*Kh=K+(rowbase+(long)t0*KVBLK)*DM,*Vh=V+(rowbase+(long)t0*KVBLK)*DM;
  const unsigned lds0=(unsigned)(uintptr_t)shm;
  float*wsf=(float*)(shm+LDS_WS)+wid*64;
  const unsigned ksrc=(unsigned)(lane*DM+wid*8)*2u;
  const unsigned vsrc=(unsigned)((16*(wid&3)+(lane>>2))*DM+(wid>>2)*32+(lane&3)*8)*2u;
  const unsigned kdst=lds0+LDS_K+wid*1024, vdst=lds0+LDS_V+wid*1024;
  #define DMA_K(t,slot) glds16sf(Kh,ksrc+(unsigned)(t)*(KVBLK*DM*2),(unsigned)__builtin_amdgcn_readfirstlane(kdst+(slot)))
  #define DMA_V(t,slot) glds16sf(Vh,vsrc+(unsigned)(t)*(KVBLK*DM*2),(unsigned)__builtin_amdgcn_readfirstlane(vdst+(slot)))
  const int vb0=(int)(lds0+LDS_V)+((lane>>4)&1)*32+(lane&3)*8+(4*hi+((lane&15)>>2))*64;
  const char*Kbase=shm+LDS_K; bf16x8 kf[8];
  const lds_cptr shm3=(lds_cptr)shm; const lds_cptr kp0=shm3+LDS_K+hi*1024+r32*16; const lds_cptr vp0=shm3+LDS_V+((lane>>4)&1)*32+(lane&3)*8+(4*hi+((lane&15)>>2))*64;
  const int NT=(q0+QB)/KVBLK-t0;
  DMA_K(0,0);DMA_V(0,0);DMA_K(1,SLOTB);
  bf16x8 qr[4];
  #pragma unroll
  for(int d0=0;d0<4;++d0)qr[d0]=*reinterpret_cast<const bf16x8*>(&Qw[(long)r32*DM+d0*16+hi*8]);
  float mhat=0.f,l_reg=0.f;f32x16 o[2];o[0]=f32x16{};o[1]=f32x16{};
  const u32x4 fbA=hi?u32x4{0x3f803f80u,0x3f80u,0u,0u}:u32x4{0u,0u,0u,0u}; u32x4 fbB=u32x4{0u,0u,0u,0u};
  #define FSPLIT3(x,H,M,L) do{ H=cvtpk_s((x),0.f)&0xffffu; const float r1_=(x)-__uint_as_float(H<<16); M=cvtpk_s(r1_,0.f)&0xffffu; const float r2_=r1_-__uint_as_float(M<<16); L=cvtpk_s(r2_,0.f)&0xffffu; }while(0)
  #define FMUPD() do{ const float nm_=-mhat; unsigned h_,m_,l_; FSPLIT3(nm_,h_,m_,l_); if(hi){ fbB[0]=h_|(m_<<16); fbB[1]=l_; } asm volatile("":"+v"(fbB)); }while(0)
  #define FBMF(C0,C1) do{ C0=__builtin_amdgcn_mfma_f32_32x32x16_bf16(__builtin_bit_cast(bf16x8,fbA),__builtin_bit_cast(bf16x8,fbB),C0,0,0,0); C1=__builtin_amdgcn_mfma_f32_32x32x16_bf16(__builtin_bit_cast(bf16x8,fbA),__builtin_bit_cast(bf16x8,fbB),C1,0,0,0); }while(0)
  const lds_cptr tb3=(lds_cptr)shm+LDS_TAB+t0*256+hi*16;
  #define BLD(C0,C1,t,g_) do{ const __attribute__((address_space(3))) f32x4_t* bp_=(const __attribute__((address_space(3))) f32x4_t*)(tb3+(t)*256); const f32x4_t x0_=bp_[2*(g_)], x1_=bp_[8+2*(g_)]; \
      C0[4*(g_)]=x0_[0];C0[4*(g_)+1]=x0_[1];C0[4*(g_)+2]=x0_[2];C0[4*(g_)+3]=x0_[3]; C1[4*(g_)]=x1_[0];C1[4*(g_)+1]=x1_[1];C1[4*(g_)+2]=x1_[2];C1[4*(g_)+3]=x1_[3]; }while(0)
  #define BLD4(C0,C1,t) do{ BLD(C0,C1,t,0); BLD(C0,C1,t,1); BLD(C0,C1,t,2); BLD(C0,C1,t,3); }while(0)
  const int qrel=wid*QBLK+r32;
  #define CMASK(P0,P1,t) do{int jb_=(t)-(NT-4); if(jb_>=0){ if(MODE==0)cmask(P0,P1,jb_,qrel,hi); else dmask(P0,P1,jb_,qrel,hi,s2);} }while(0)
  bool resc=false; constexpr float TH2_=(float)(1ull<<THRL);
  #define START(P0,P1) do{ const float rm=rowmax(P0,P1); resc=false; mhat=rm; FMUPD(); \
    _Pragma("unroll") for(int r=0;r<16;++r){P0[r]=fsub_s(P0[r],mhat);P1[r]=fsub_s(P1[r],mhat);} \
    _Pragma("unroll") for(int r=0;r<16;++r)P0[r]=__builtin_amdgcn_exp2f(P0[r]); }while(0)
  #define RESC() do{ if(resc){ asm volatile("s_waitcnt lgkmcnt(0)":::"memory"); \
      _Pragma("unroll") for(int d_=0;d_<2;++d_) _Pragma("unroll") for(int r=0;r<16;++r)o[d_][r]*=wsf[crow(r,hi)]; } }while(0)
  f32x16 pA0,pA1,pB0,pB1;
  int sl_prev=0,sl_cur=0,sl_next=SLOTB;
  #define ROT() do{sl_prev=sl_cur;sl_cur=sl_next;sl_next=(sl_next==(NSLOT-1)*SLOTB)?0:sl_next+SLOTB;}while(0)
  DMA_K(2,2*SLOTB);
  WAIT_BAR(3);
  BLD4(pA0,pA1,0); qkt(pA0,pA1,Kbase,qr,r32,hi);asm volatile("s_nop 15\n\ts_nop 7":"+v"(pA0),"+v"(pA1));CMASK(pA0,pA1,0);
  START(pA0,pA1);
  _Pragma("unroll") for(int r=0;r<16;++r)pA1[r]=__builtin_amdgcn_exp2f(pA1[r]);
  WAIT_BAR(0);
  DMA_K(3,0);DMA_V(1,SLOTB);
  ROT();
  kload8(kf,kp0+sl_cur);
  WAIT_BAR(2);
  s16x4 vlo[8],vhi[8]; u32x4 pw0,pw1,pw2,pw3;
  #define PKW(P,B) cvtpk_s(P[B],P[B+1])
  #define PAF(k) __builtin_bit_cast(bf16x8,pw##k)
  #define VFR(i) (bf16x8){vlo[i][0],vlo[i][1],vlo[i][2],vlo[i][3],vhi[i][0],vhi[i][1],vhi[i][2],vhi[i][3]}
  #define PIN(x) asm volatile("":"+v"(x))
  #define MX3(a,b,c) __builtin_fmaxf(__builtin_fmaxf((a),(b)),(c))
  #define GAPA(MF,A0,A1,A2,A3,W0,W1,PW) do{ MF; sacc+=A0; sacc+=A1; sacc+=A2; sacc+=A3; PIN(sacc); W0; W1; PIN(PW); SBAR(); }while(0)
  #define EX(v) __builtin_amdgcn_exp2f(v)
  #define GAPB(MF,X,B) do{ MF; X[B]=EX(X[B]); X[B+1]=EX(X[B+1]); X[B+2]=EX(X[B+2]); X[B+3]=EX(X[B+3]); PIN(X); SBAR(); }while(0)
  #define VRD(i) do{ vlo[i]=vtr(vp_+(((i)>>2)*4096+((i)&3)*1024)); vhi[i]=vtr(vp_+(((i)>>2)*4096+((i)&3)*1024+512)); }while(0)
  #define KRD(G,j) do{ if(G){ kload2(kf,kp0+sl_next,j); SBAR(); } }while(0)
  #define STEP(C0,C1,P0,P1,t,GK,GV,GL) do{ SBAR(); \
    const lds_cptr vp_=vp0+sl_prev; \
    VRD(0); SBAR(); float sacc=(P0[0]+P0[1]); \
    GAPA(C0=__builtin_amdgcn_mfma_f32_32x32x16_bf16(kf[0],qr[0],C0,0,0,0), P0[2],P0[3],P0[4],P0[5],     pw0[0]=PKW(P0,0), pw0[1]=PKW(P0,2), pw0); \
    VRD(4); SBAR(); GAPA(C1=__builtin_amdgcn_mfma_f32_32x32x16_bf16(kf[1],qr[0],C1,0,0,0), P0[6],P0[7],P0[8],P0[9],     pw0[2]=PKW(P0,4), pw0[3]=PKW(P0,6), pw0); \
    VRD(1); SBAR(); GAPA(C0=__builtin_amdgcn_mfma_f32_32x32x16_bf16(kf[2],qr[1],C0,0,0,0),   P0[10],P0[11],P0[12],P0[13], pw1[0]=PKW(P0,8), pw1[1]=PKW(P0,10), pw1); \
    VRD(5); SBAR(); GAPA(C1=__builtin_amdgcn_mfma_f32_32x32x16_bf16(kf[3],qr[1],C1,0,0,0),   P0[14],P0[15],P1[0],P1[1],   pw1[2]=PKW(P0,12),pw1[3]=PKW(P0,14), pw1); \
    VRD(2); SBAR(); GAPA(C0=__builtin_amdgcn_mfma_f32_32x32x16_bf16(kf[4],qr[2],C0,0,0,0),   P1[2],P1[3],P1[4],P1[5],     pw2[0]=PKW(P1,0), pw2[1]=PKW(P1,2), pw2); \
    VRD(6); SBAR(); GAPA(C1=__builtin_amdgcn_mfma_f32_32x32x16_bf16(kf[5],qr[2],C1,0,0,0),   P1[6],P1[7],P1[8],P1[9],     pw2[2]=PKW(P1,4), pw2[3]=PKW(P1,6), pw2); \
    VRD(3); SBAR(); GAPA(C0=__builtin_amdgcn_mfma_f32_32x32x16_bf16(kf[6],qr[3],C0,0,0,0),   P1[10],P1[11],P1[12],P1[13], pw3[0]=PKW(P1,8), pw3[1]=PKW(P1,10), pw3); \
    VRD(7); SBAR(); GAPA(C1=__builtin_amdgcn_mfma_f32_32x32x16_bf16(kf[7],qr[3],C1,0,0,0),   P1[14],P1[15],0.f,0.f,       pw3[2]=PKW(P1,12),pw3[3]=PKW(P1,14), pw3); \
    l_reg+=sacc; \
    if(GK){DMA_K((t)+3,sl_cur);} if(GV){DMA_V((t)+1,sl_next);} \
    CMASK(C0,C1,t); \
    { resc=false; \
      if(__builtin_expect(__any(sacc>TH2_),0)){ float rs; { auto rr=__builtin_amdgcn_permlane32_swap(__float_as_uint(sacc),__float_as_uint(sacc),false,false); rs=__uint_as_float(rr[0])+__uint_as_float(rr[1]); } \
        const float dl=__builtin_fmaxf(__builtin_amdgcn_logf(rs),0.f); mhat+=dl; FMUPD(); \
        const float f=__builtin_amdgcn_exp2f(-dl); l_reg*=f; if(hi==0)wsf[r32]=f; resc=true; } } \
    FBMF(C0,C1); \
    SBAR(); \
    BLD(P0,P1,(t)+1,0); SBAR(); GAPB(o[0]=__builtin_amdgcn_mfma_f32_32x32x16_bf16(PAF(0),VFR(0),o[0],0,0,0), C0,0); \
    BLD(P0,P1,(t)+1,1); SBAR(); GAPB(o[1]=__builtin_amdgcn_mfma_f32_32x32x16_bf16(PAF(0),VFR(4),o[1],0,0,0), C0,4); \
    KRD(GL,0); GAPB(o[0]=__builtin_amdgcn_mfma_f32_32x32x16_bf16(PAF(1),VFR(1),o[0],0,0,0), C0,8); \
    KRD(GL,1); GAPB(o[1]=__builtin_amdgcn_mfma_f32_32x32x16_bf16(PAF(1),VFR(5),o[1],0,0,0), C0,12); \
    KRD(GL,2); GAPB(o[0]=__builtin_amdgcn_mfma_f32_32x32x16_bf16(PAF(2),VFR(2),o[0],0,0,0), C1,0); \
    KRD(GL,3); GAPB(o[1]=__builtin_amdgcn_mfma_f32_32x32x16_bf16(PAF(2),VFR(6),o[1],0,0,0), C1,4); \
    BLD(P0,P1,(t)+1,2); SBAR(); GAPB(o[0]=__builtin_amdgcn_mfma_f32_32x32x16_bf16(PAF(3),VFR(3),o[0],0,0,0), C1,8); \
    BLD(P0,P1,(t)+1,3); SBAR(); GAPB(o[1]=__builtin_amdgcn_mfma_f32_32x32x16_bf16(PAF(3),VFR(7),o[1],0,0,0), C1,12); \
    }while(0)
  BLD4(pB0,pB1,1);
  int t=1;
  #undef CMASK
  #define CMASK(P0,P1,t) do{}while(0)
  for(;t+5<NT;t+=2){
    STEP(pB0,pB1,pA0,pA1,t,true,true,true);     WAIT_BAR(2); RESC(); ROT();
    STEP(pA0,pA1,pB0,pB1,t+1,true,true,true);   WAIT_BAR(2); RESC(); ROT();
  }
  #undef CMASK
  #define CMASK(P0,P1,t) do{int jb_=(t)-(NT-4); if(jb_>=0){ if(MODE==0)cmask(P0,P1,jb_,qrel,hi); else dmask(P0,P1,jb_,qrel,hi,s2);} }while(0)
  #define ENDW(tt) do{ if((tt)+3<NT){WAIT_BAR(2);} else if((tt)+2<NT){WAIT_BAR(1);} else {WAIT_BAR(0);} }while(0)
  for(;t+1<NT;t+=2){
    STEP(pB0,pB1,pA0,pA1,t,(t+3<NT),(t+1<NT),(t+1<NT));       ENDW(t);   RESC(); ROT();
    STEP(pA0,pA1,pB0,pB1,t+1,(t+4<NT),(t+2<NT),(t+2<NT));     ENDW(t+1); RESC(); ROT();
  }
  STEP(pB0,pB1,pA0,pA1,NT-1,false,false,false); RESC();
  if((wid>>1)>=3){ float sacc=pB0[0]+pB0[1]; _Pragma("unroll") for(int r=2;r<16;++r)sacc+=pB0[r]; _Pragma("unroll") for(int r=0;r<16;++r)sacc+=pB1[r]; l_reg+=sacc;
    pw0=(u32x4){PKW(pB0,0),PKW(pB0,2),PKW(pB0,4),PKW(pB0,6)};pw1=(u32x4){PKW(pB0,8),PKW(pB0,10),PKW(pB0,12),PKW(pB0,14)};pw2=(u32x4){PKW(pB1,0),PKW(pB1,2),PKW(pB1,4),PKW(pB1,6)};pw3=(u32x4){PKW(pB1,8),PKW(pB1,10),PKW(pB1,12),PKW(pB1,14)};
    SBAR(); pv(o,vb0+sl_cur,PAF(0),PAF(1),PAF(2),PAF(3)); }
  #undef PKW
  #undef PAF
  #undef VFR
  #undef PIN
  #undef MX3
  #undef GAPA
  #undef GAPB
  #undef EX
  #undef VRD
  #undef KRD
  #undef STEP
  #undef ENDW
  #undef FSPLIT3
  #undef FMUPD
  #undef FBMF
  {auto rr=__builtin_amdgcn_permlane32_swap(__float_as_uint(l_reg),__float_as_uint(l_reg),false,false);l_reg=__uint_as_float(rr[0])+__uint_as_float(rr[1]);}
  if(hi==0)wsf[32+r32]=l_reg;asm volatile("s_waitcnt lgkmcnt(0)":::"memory");
  float rli[16];
  #pragma unroll
  for(int r=0;r<16;++r)rli[r]=__builtin_amdgcn_rcpf(wsf[32+crow(r,hi)]);
  bf16*Ow=O+(rowbase+q0+wid*QBLK)*DM;
  { bf16*stg=(bf16*)(shm+LDS_OST)+wid*2048;
    #pragma unroll
    for(int r=0;r<16;++r){const int orow=crow(r,hi);
      #pragma unroll
      for(int d0=0;d0<2;++d0)stg[orow*64+d0*32+r32]=__float2bfloat16(o[d0][r]*rli[r]);}
    asm volatile("s_waitcnt lgkmcnt(0)":::"memory");
    #pragma unroll
    for(int i=0;i<4;++i){const int row=i*8+(lane>>3),ch=lane&7; const u32x4 v=*(const u32x4*)(stg+row*64+ch*8); ATTN_STORE16(Ow+(long)row*DM+ch*8,v);} }
  asm volatile("s_waitcnt lgkmcnt(0)\n\ts_barrier":::"memory");
  #undef DMA_K
  #undef DMA_V
  #undef CMASK
  #undef START
  #undef RESC
  #undef BLD
  #undef BLD4
  #undef ROT
}
constexpr int ATTN_LDS_BYTES=LDS_BYTES;
namespace d128 {
constexpr int L_K=0, VSLOT=16384, L_V=NSLOT*SLOTB, L_WS=L_V+NSLOT*VSLOT, L_OST=L_WS+NW*64*4, L_END=L_OST+NW*8192;
static_assert(L_END<=LDS_BYTES,"dv=128 unit LDS layout fits the attention scratch");
}
__device__ __forceinline__ void glds16s(const void*sbase,unsigned voff,unsigned lds_dst){unsigned keep;
  asm volatile("s_mov_b32 %0, m0\n\ts_mov_b32 m0, %3\n\ts_nop 0\n\tglobal_load_lds_dwordx4 %1, %2\n\ts_mov_b32 m0, %0":"=&s"(keep):"v"(voff),"s"(sbase),"s"(lds_dst):"memory");}
template<int THRL> __device__ __forceinline__ void attn_unit_d128(long rowbase,int qb,int t0,const bf16*Q,const bf16*__restrict__ K,const bf16*__restrict__ V,bf16*O,char*shm,float s2){
  using namespace d128;
  int tid_=threadIdx.x; asm volatile("":"+v"(tid_)); const int tid=tid_,lane=tid&63,r32=lane&31,hi=lane>>5; const int wid=__builtin_amdgcn_readfirstlane(tid>>6);
  const int q0=qb*QB;
  const bf16*Qw=Q+(rowbase+q0+wid*QBLK)*DM;
  const bf16*Kh=K+(rowbase+(long)t0*KVBLK)*DM,*Vh=V+(rowbase+(long)t0*KVBLK)*DM;
  const unsigned lds0=(unsigned)(uintptr_t)shm;
  __attribute__((address_space(3))) float*wsf=(__attribute__((address_space(3))) float*)((lds_cptr)shm+L_WS)+wid*64;
  const unsigned koff=(unsigned)(lane*DM+wid*8)*2u;
  const unsigned voff=(unsigned)((16*(wid&3)+(lane>>2))*DM+(wid>>2)*32+(lane&3)*8)*2u;
  const unsigned kdst=lds0+L_K+wid*1024, vdst=lds0+L_V+wid*1024;
  const bool lo4=wid<4;
  #define RFL(x) ((unsigned)__builtin_amdgcn_readfirstlane(x))
  #define DMA_K(t,slot) do{ if(lo4){ glds16s(Kh,koff+(unsigned)(t)*(KVBLK*DM*2),RFL(kdst+(slot))); glds16s(Kh,koff+64u+(unsigned)(t)*(KVBLK*DM*2),RFL(kdst+(slot)+4096)); } }while(0)
  #define DMA_V(t,slot) do{ if(lo4){ glds16s(Vh,voff+(unsigned)(t)*(KVBLK*DM*2),RFL(vdst+2*(slot))); glds16s(Vh,voff+128u+(unsigned)(t)*(KVBLK*DM*2),RFL(vdst+2*(slot)+8192)); \
      glds16s(Vh,voff+64u+(unsigned)(t)*(KVBLK*DM*2),RFL(vdst+2*(slot)+4096)); glds16s(Vh,voff+192u+(unsigned)(t)*(KVBLK*DM*2),RFL(vdst+2*(slot)+12288)); } }while(0)
  const char*Kbase=shm+L_K; bf16x8 kf[8];
  const lds_cptr shm3=(lds_cptr)shm; const lds_cptr kp0=shm3+L_K+hi*1024+r32*16; const lds_cptr vp0=shm3+L_V+((lane>>4)&1)*32+(lane&3)*8+(4*hi+((lane&15)>>2))*64;
  const int NT=(q0+QB)/KVBLK-t0;
  DMA_K(0,0);DMA_V(0,0);DMA_K(1,SLOTB);
  bf16x8 qr[4];
  #pragma unroll
  for(int d0=0;d0<4;++d0)qr[d0]=*reinterpret_cast<const bf16x8*>(&Qw[(long)r32*DM+d0*16+hi*8]);
  float mhat=0.f,l_reg=0.f;f32x16 o[4];o[0]=f32x16{};o[1]=f32x16{};o[2]=f32x16{};o[3]=f32x16{};
  const float sl2_=0.5f*s2; const int bofs_=64*t0-q0;
  #define SPLIT3(x,H,M,L) do{ H=cvtpk_s((x),0.f)&0xffffu; const float r1_=(x)-__uint_as_float(H<<16); M=cvtpk_s(r1_,0.f)&0xffffu; const float r2_=r1_-__uint_as_float(M<<16); L=cvtpk_s(r2_,0.f)&0xffffu; }while(0)
  u32x4 bA0,bA1;
  { unsigned h_,m_,l_,hs_,ms_,ls_; const float st_=64.f*sl2_; SPLIT3(st_,hs_,ms_,ls_);
    const float j0=sl2_*(float)(r32+bofs_), j1=sl2_*(float)(r32+32+bofs_);
    SPLIT3(j0,h_,m_,l_); bA0=hi?u32x4{0x3f803f80u,0x3f80u,0u,0u}:u32x4{h_|(m_<<16),l_|(hs_<<16),ms_|(ls_<<16),0u};
    SPLIT3(j1,h_,m_,l_); bA1=hi?u32x4{0x3f803f80u,0x3f80u,0u,0u}:u32x4{h_|(m_<<16),l_|(hs_<<16),ms_|(ls_<<16),0u}; }
  u32x4 bB=(hi==0)?u32x4{0x3f803f80u,0x3f80u,0u,0u}:u32x4{0u,0u,0u,0u};
  const unsigned lom_=hi?0u:0xffffffffu;
  #define BUPD(t) do{ const unsigned x_=__float_as_uint((float)(t))&lom_; bB[1]=(bB[1]&0xffffu)|x_; bB[2]=__builtin_amdgcn_perm(x_,x_,0x03020302u); }while(0)
  #define MUPD() do{ const float nm_=-mhat; unsigned h_,m_,l_; SPLIT3(nm_,h_,m_,l_); if(hi){ bB[0]=h_|(m_<<16); bB[1]=l_; } asm volatile("":"+v"(bB)); }while(0)
  #define BMF(C0,C1) do{ C0=__builtin_amdgcn_mfma_f32_32x32x16_bf16(__builtin_bit_cast(bf16x8,bA0),__builtin_bit_cast(bf16x8,bB),C0,0,0,0); C1=__builtin_amdgcn_mfma_f32_32x32x16_bf16(__builtin_bit_cast(bf16x8,bA1),__builtin_bit_cast(bf16x8,bB),C1,0,0,0); }while(0)
  #define CMASK(P0,P1,t) do{int jb_=(t)-(NT-4); if(jb_>=0)dmask(P0,P1,jb_,wid*QBLK+r32,hi,2.f*sl2_); }while(0)
  bool resc=false; constexpr float TH2_=(float)(1ull<<THRL);
  #define START(P0,P1) do{ const float rm=rowmax(P0,P1); resc=false; mhat=rm; \
    _Pragma("unroll") for(int r=0;r<16;++r){P0[r]=fsub_s(P0[r],mhat);P1[r]=fsub_s(P1[r],mhat);} \
    MUPD(); \
    _Pragma("unroll") for(int r=0;r<16;++r)P0[r]=__builtin_amdgcn_exp2f(P0[r]); }while(0)
  #define RESC() do{ if(resc){ asm volatile("s_waitcnt lgkmcnt(0)":::"memory"); \
      _Pragma("unroll") for(int d_=0;d_<4;++d_) _Pragma("unroll") for(int r=0;r<16;++r)o[d_][r]*=wsf[crow(r,hi)]; } }while(0)
  f32x16 pA0,pA1,pB0,pB1;
  int sl_prev=0,sl_cur=0,sl_next=SLOTB;
  #define ROT() do{sl_prev=sl_cur;sl_cur=sl_next;sl_next=(sl_next==(NSLOT-1)*SLOTB)?0:sl_next+SLOTB;}while(0)
  DMA_K(2,2*SLOTB);
  WAIT_BAR(8);
  pA0=f32x16{}; pA1=f32x16{}; BUPD(0); qkt(pA0,pA1,Kbase,qr,r32,hi); BMF(pA0,pA1); asm volatile("s_nop 15\n\ts_nop 7":"+v"(pA0),"+v"(pA1)); CMASK(pA0,pA1,0);
  START(pA0,pA1);
  _Pragma("unroll") for(int r=0;r<16;++r)pA1[r]=__builtin_amdgcn_exp2f(pA1[r]);
  WAIT_BAR(0);
  DMA_K(3,0);DMA_V(1,SLOTB);
  ROT();
  kload8(kf,kp0+sl_cur);
  WAIT_BAR(6);
  bf16x8 vfa[8],vfb[8]; u32x4 pw0,pw1,pw2,pw3;
  #define PKW(P,B) cvtpk_s(P[B],P[B+1])
  #define PAF(k) __builtin_bit_cast(bf16x8,pw##k)
  #define PIN(x) asm volatile("":"+v"(x))
  #define MX3(a,b,c) __builtin_fmaxf(__builtin_fmaxf((a),(b)),(c))
  #define GAPA(MF,A0,A1,A2,A3,W0,W1,PW) do{ MF; sacc+=A0; sacc+=A1; sacc+=A2; sacc+=A3; PIN(sacc); W0; W1; PIN(PW); SBAR(); }while(0)
  #define EX(v) __builtin_amdgcn_exp2f(v)
  #define VOFF(g) ((((g)&3)*4096)+(((g)>>2)*1024))
  #define VRDF(dst,g) do{ const s16x4 lo_=vtr(vp_+VOFF(g)), hi_=vtr(vp_+VOFF(g)+512); dst=(bf16x8){lo_[0],lo_[1],lo_[2],lo_[3],hi_[0],hi_[1],hi_[2],hi_[3]}; }while(0)
  #define GAPP(MF,X,B,RD) do{ RD; SBAR(); MF; X[B]=EX(X[B]); X[B+1]=EX(X[B+1]); PIN(X); SBAR(); }while(0)
  #define KRD(G,j) do{ if(G){ kload2(kf,kp0+sl_next,j); SBAR(); } }while(0)
  #define PVM(k,db,vf) o[db]=__builtin_amdgcn_mfma_f32_32x32x16_bf16(PAF(k),vf,o[db],0,0,0)
  #define STEP(C0,C1,P0,P1,t,GK,GV,GL) do{ SBAR(); \
    const lds_cptr vp_=vp0+2*sl_prev; const f32x16 zc_=f32x16{}; \
    float sacc=(P0[0]+P0[1]); \
    GAPA(C0=__builtin_amdgcn_mfma_f32_32x32x16_bf16(kf[0],qr[0],zc_,0,0,0), P0[2],P0[3],P0[4],P0[5],     pw0[0]=PKW(P0,0), pw0[1]=PKW(P0,2), pw0); \
    VRDF(vfa[0],0); SBAR(); \
    GAPA(C1=__builtin_amdgcn_mfma_f32_32x32x16_bf16(kf[1],qr[0],zc_,0,0,0), P0[6],P0[7],P0[8],P0[9],     pw0[2]=PKW(P0,4), pw0[3]=PKW(P0,6), pw0); \
    VRDF(vfa[1],1); BUPD(t); PIN(bB); SBAR(); \
    GAPA(C0=__builtin_amdgcn_mfma_f32_32x32x16_bf16(kf[2],qr[1],C0,0,0,0),   P0[10],P0[11],P0[12],P0[13], pw1[0]=PKW(P0,8), pw1[1]=PKW(P0,10), pw1); \
    VRDF(vfa[2],2); SBAR(); \
    GAPA(C1=__builtin_amdgcn_mfma_f32_32x32x16_bf16(kf[3],qr[1],C1,0,0,0),   P0[14],P0[15],P1[0],P1[1],   pw1[2]=PKW(P0,12),pw1[3]=PKW(P0,14), pw1); \
    VRDF(vfa[3],3); SBAR(); \
    GAPA(C0=__builtin_amdgcn_mfma_f32_32x32x16_bf16(kf[4],qr[2],C0,0,0,0),   P1[2],P1[3],P1[4],P1[5],     pw2[0]=PKW(P1,0), pw2[1]=PKW(P1,2), pw2); \
    VRDF(vfa[4],4); SBAR(); \
    GAPA(C1=__builtin_amdgcn_mfma_f32_32x32x16_bf16(kf[5],qr[2],C1,0,0,0),   P1[6],P1[7],P1[8],P1[9],     pw2[2]=PKW(P1,4), pw2[3]=PKW(P1,6), pw2); \
    VRDF(vfa[5],5); SBAR(); \
    GAPA(C0=__builtin_amdgcn_mfma_f32_32x32x16_bf16(kf[6],qr[3],C0,0,0,0),   P1[10],P1[11],P1[12],P1[13], pw3[0]=PKW(P1,8), pw3[1]=PKW(P1,10), pw3); \
    VRDF(vfa[6],6); SBAR(); \
    GAPA(C1=__builtin_amdgcn_mfma_f32_32x32x16_bf16(kf[7],qr[3],C1,0,0,0),   P1[14],P1[15],0.f,0.f,       pw3[2]=PKW(P1,12),pw3[3]=PKW(P1,14), pw3); \
    VRDF(vfa[7],7); SBAR(); \
    l_reg+=sacc; \
    { resc=false; \
      if(__builtin_expect(__any(sacc>TH2_),0)){ float rs; { auto rr=__builtin_amdgcn_permlane32_swap(__float_as_uint(sacc),__float_as_uint(sacc),false,false); rs=__uint_as_float(rr[0])+__uint_as_float(rr[1]); } \
        const float dl=__builtin_fmaxf(__builtin_amdgcn_logf(rs),0.f); mhat+=dl; \
        MUPD(); \
        const float f=__builtin_amdgcn_exp2f(-dl); l_reg*=f; if(hi==0)wsf[r32]=f; resc=true; } } \
    BMF(C0,C1); \
    if(GK){DMA_K((t)+3,sl_cur);} if(GV){DMA_V((t)+1,sl_next);} \
    CMASK(C0,C1,t); \
    SBAR(); \
    GAPP(PVM(0,0,vfa[0]), C0,0,  (void)0); VRDF(vfb[0],8); SBAR(); \
    GAPP(PVM(0,1,vfa[1]), C0,2,  (void)0); VRDF(vfb[1],9); SBAR(); \
    GAPP(PVM(0,2,vfa[2]), C0,4,  (void)0); VRDF(vfb[2],10); SBAR(); \
    GAPP(PVM(0,3,vfa[3]), C0,6,  (void)0); VRDF(vfb[3],11); SBAR(); \
    GAPP(PVM(1,0,vfa[4]), C0,8,  (void)0); VRDF(vfb[4],12); SBAR(); \
    GAPP(PVM(1,1,vfa[5]), C0,10, (void)0); VRDF(vfb[5],13); SBAR(); \
    GAPP(PVM(1,2,vfa[6]), C0,12, (void)0); VRDF(vfb[6],14); SBAR(); \
    GAPP(PVM(1,3,vfa[7]), C0,14, (void)0); VRDF(vfb[7],15); SBAR(); \
    GAPP(PVM(2,0,vfb[0]), C1,0,  (void)0); \
    GAPP(PVM(2,1,vfb[1]), C1,2,  (void)0); KRD(GL,0); \
    GAPP(PVM(2,2,vfb[2]), C1,4,  (void)0); \
    GAPP(PVM(2,3,vfb[3]), C1,6,  (void)0); KRD(GL,1); \
    GAPP(PVM(3,0,vfb[4]), C1,8,  (void)0); \
    GAPP(PVM(3,1,vfb[5]), C1,10, (void)0); KRD(GL,2); \
    GAPP(PVM(3,2,vfb[6]), C1,12, (void)0); \
    GAPP(PVM(3,3,vfb[7]), C1,14, (void)0); KRD(GL,3); \
    }while(0)
  int t=1;
  #undef CMASK
  #define CMASK(P0,P1,t) do{}while(0)
  for(;t+5<NT;t+=2){
    STEP(pB0,pB1,pA0,pA1,t,true,true,true);     WAIT_BAR(6); RESC(); ROT();
    STEP(pA0,pA1,pB0,pB1,t+1,true,true,true);   WAIT_BAR(6); RESC(); ROT();
  }
  #undef CMASK
  #define CMASK(P0,P1,t) do{int jb_=(t)-(NT-4); if(jb_>=0)dmask(P0,P1,jb_,wid*QBLK+r32,hi,2.f*sl2_); }while(0)
  #define ENDW(tt) do{ if((tt)+3<NT){WAIT_BAR(6);} else if((tt)+2<NT){WAIT_BAR(4);} else {WAIT_BAR(0);} }while(0)
  for(;t+1<NT;t+=2){
    STEP(pB0,pB1,pA0,pA1,t,(t+3<NT),(t+1<NT),(t+1<NT));       ENDW(t);   RESC(); ROT();
    STEP(pA0,pA1,pB0,pB1,t+1,(t+4<NT),(t+2<NT),(t+2<NT));     ENDW(t+1); RESC(); ROT();
  }
  STEP(pB0,pB1,pA0,pA1,NT-1,false,false,false); RESC();
  if((wid>>1)>=3){ float sacc=pB0[0]+pB0[1]; _Pragma("unroll") for(int r=2;r<16;++r)sacc+=pB0[r]; _Pragma("unroll") for(int r=0;r<16;++r)sacc+=pB1[r]; l_reg+=sacc;
    pw0=(u32x4){PKW(pB0,0),PKW(pB0,2),PKW(pB0,4),PKW(pB0,6)};pw1=(u32x4){PKW(pB0,8),PKW(pB0,10),PKW(pB0,12),PKW(pB0,14)};pw2=(u32x4){PKW(pB1,0),PKW(pB1,2),PKW(pB1,4),PKW(pB1,6)};pw3=(u32x4){PKW(pB1,8),PKW(pB1,10),PKW(pB1,12),PKW(pB1,14)};
    SBAR(); const lds_cptr vp_=vp0+2*sl_cur;
    #pragma unroll
    for(int db=0;db<4;++db){ s16x4 a0=vtr(vp_+db*4096),b0=vtr(vp_+db*4096+512),a1=vtr(vp_+db*4096+1024),b1=vtr(vp_+db*4096+1536),a2=vtr(vp_+db*4096+2048),b2=vtr(vp_+db*4096+2560),a3=vtr(vp_+db*4096+3072),b3=vtr(vp_+db*4096+3584);
      #define PK2(a,b) (bf16x8){a[0],a[1],a[2],a[3],b[0],b[1],b[2],b[3]}
      o[db]=__builtin_amdgcn_mfma_f32_32x32x16_bf16(PAF(0),PK2(a0,b0),o[db],0,0,0); o[db]=__builtin_amdgcn_mfma_f32_32x32x16_bf16(PAF(1),PK2(a1,b1),o[db],0,0,0);
      o[db]=__builtin_amdgcn_mfma_f32_32x32x16_bf16(PAF(2),PK2(a2,b2),o[db],0,0,0); o[db]=__builtin_amdgcn_mfma_f32_32x32x16_bf16(PAF(3),PK2(a3,b3),o[db],0,0,0);
      #undef PK2
    } }
  #undef PKW
  #undef PAF
  #undef PIN
  #undef MX3
  #undef GAPA
  #undef GAPP
  #undef EX
  #undef VOFF
  #undef VRDF
  #undef KRD
  #undef PVM
  #undef STEP
  #undef ENDW
  {auto rr=__builtin_amdgcn_permlane32_swap(__float_as_uint(l_reg),__float_as_uint(l_reg),false,false);l_reg=__uint_as_float(rr[0])+__uint_as_float(rr[1]);}
  if(hi==0)wsf[32+r32]=l_reg;asm volatile("s_waitcnt lgkmcnt(0)":::"memory");
  float rli[16];
  #pragma unroll
  for(int r=0;r<16;++r)rli[r]=__builtin_amdgcn_rcpf(wsf[32+crow(r,hi)]);
  bf16*Ow=O+(rowbase+q0+wid*QBLK)*DM;
  { bf16*stg=(bf16*)(shm+L_OST)+wid*4096;
    #pragma unroll
    for(int r=0;r<16;++r){const int orow=crow(r,hi);
      #pragma unroll
      for(int db=0;db<4;++db)stg[orow*128+db*32+r32]=__float2bfloat16(o[db][r]*rli[r]);}
    asm volatile("s_waitcnt lgkmcnt(0)":::"memory");
    #pragma unroll
    for(int i=0;i<8;++i){const int row=i*4+(lane>>4),ch=lane&15; const u32x4 v=*(const u32x4*)(stg+row*128+ch*8); ATTN_STORE16(Ow+(long)row*DM+ch*8,v);} }
  asm volatile("s_waitcnt lgkmcnt(0)\n\ts_barrier":::"memory");
  #undef DMA_K
  #undef RFL
  #undef DMA_V
  #undef CMASK
  #undef START
  #undef RESC
  #undef ROT
  #undef SPLIT3
  #undef BUPD
  #undef MUPD
  #undef BMF
}
#undef SBAR
#undef WAIT_BAR
}
#define GAS __attribute__((address_space(1)))
#define LAS __attribute__((address_space(3)))
typedef unsigned short bf16;
typedef unsigned v4u __attribute__((ext_vector_type(4)));
typedef float f32x4 __attribute__((ext_vector_type(4)));
typedef short bf16x8 __attribute__((ext_vector_type(8)));
typedef GAS unsigned gu32;
typedef GAS unsigned long long gu64;
#define RLX_AGENT __ATOMIC_RELAXED, __HIP_MEMORY_SCOPE_AGENT
#define LDS_WAIT() asm volatile("s_waitcnt lgkmcnt(0)" ::: "memory")
#define VM_WAIT() asm volatile("s_waitcnt vmcnt(0)" ::: "memory")
__device__ __forceinline__ unsigned long long rt() { return __builtin_amdgcn_s_memrealtime(); }
__device__ __forceinline__ unsigned f2bf(float f) { unsigned u = __builtin_bit_cast(unsigned, f); return (u + 0x7fffu + ((u >> 16) & 1u)) >> 16; }
__device__ __forceinline__ unsigned pk2(float lo, float hi) { return f2bf(lo) | (f2bf(hi) << 16); }

#define XB_TMO      128
#define XB_XCNT(j)  (256  + 64 * (j))
#define XB_XSUB(j)  (1280 + 64 * (j))
#define XB_XGEN(j)  (2304 + 64 * (j))
#define XB_TOP      3328
#define XB_TOPGEN   3392
#define XCD_BAR_WORDS 3456
#define XB_SPIN_CAP (1u << 18)

__device__ __forceinline__ unsigned xb_ld(unsigned* p)              { return __hip_atomic_load(p, __ATOMIC_RELAXED, __HIP_MEMORY_SCOPE_AGENT); }
__device__ __forceinline__ unsigned xb_add(unsigned* p, unsigned v) { return __hip_atomic_fetch_add(p, v, __ATOMIC_RELAXED, __HIP_MEMORY_SCOPE_AGENT); }
__device__ __forceinline__ unsigned xb_xcc_id() { return (unsigned)__builtin_amdgcn_s_getreg((3 << 11) | 20) & 0xFu; }
#define XB_SPIN(cond, bar) do { unsigned _sp = 0; while (cond) { __builtin_amdgcn_s_sleep(1); \
    if ((++_sp & 255u) == 0u) { if (xb_ld(&(bar)[XB_TMO])) break; if (_sp > XB_SPIN_CAP) { atomicAdd(&(bar)[XB_TMO], 1u); break; } } } } while (0)

struct XcdBarrier {
    unsigned* bar; unsigned x;
    volatile LAS unsigned* st;
};

__device__ __forceinline__ XcdBarrier xcd_barrier_post(unsigned* bar, volatile LAS unsigned* st) {
    XcdBarrier b; b.bar = bar; b.x = xb_xcc_id(); b.st = st;
    if (threadIdx.x == 0) (void)xb_add(&bar[XB_XCNT(b.x)], 1u);
    return b;
}
__device__ __forceinline__ void xcd_barrier_complete(unsigned* bar, unsigned x, unsigned& nloc, unsigned& nx) {
    const unsigned G = gridDim.x * gridDim.y * gridDim.z;
    unsigned sum, cnt, mine, sp = 0u;
    for (;;) {
        sum = 0u; cnt = 0u; mine = 0u;
#pragma unroll
        for (unsigned j = 0; j < 16; ++j) { const unsigned c = xb_ld(&bar[XB_XCNT(j)]); sum += c; cnt += (c > 0u) ? 1u : 0u; mine = (j == x) ? c : mine; }
        if (sum == G) break;
        __builtin_amdgcn_s_sleep(1);
        if ((++sp & 255u) == 0u) { if (xb_ld(&bar[XB_TMO])) break; if (sp > XB_SPIN_CAP) { atomicAdd(&bar[XB_TMO], 1u); break; } }
    }
    nloc = mine > 0u ? mine : 1u; nx = cnt > 0u ? cnt : 1u;
}

__device__ __forceinline__ void xcd_barrier(const XcdBarrier& b) {
    asm volatile("s_waitcnt vmcnt(0)" ::: "memory");
    __syncthreads();
    if (threadIdx.x == 0) {
        unsigned* bar = b.bar;
        __builtin_amdgcn_s_waitcnt(0);
        unsigned nloc = b.st[0], nx = b.st[1];
        if (nloc == 0u) { xcd_barrier_complete(bar, b.x, nloc, nx); b.st[0] = nloc; b.st[1] = nx; }
        const unsigned old = xb_add(&bar[XB_XSUB(b.x)], 1u);
        const unsigned gen = old / nloc;
        if (old + 1u == (gen + 1u) * nloc) {
            __builtin_amdgcn_fence(__ATOMIC_RELEASE, "agent");
            asm volatile("s_waitcnt vmcnt(0)" ::: "memory");
            const unsigned og = xb_add(&bar[XB_TOP], 1u);
            const unsigned tg = og / nx;
            if (og + 1u == (tg + 1u) * nx) xb_add(&bar[XB_TOPGEN], 1u);
            else XB_SPIN(xb_ld(&bar[XB_TOPGEN]) == tg, bar);
            __builtin_amdgcn_fence(__ATOMIC_ACQUIRE, "agent");
            xb_add(&bar[XB_XGEN(b.x)], 1u);
            asm volatile("s_waitcnt vmcnt(0)" ::: "memory");
        } else {
            XB_SPIN(xb_ld(&bar[XB_XGEN(b.x)]) == gen, bar);
            __builtin_amdgcn_fence(__ATOMIC_ACQUIRE, "agent");
            asm volatile("s_waitcnt vmcnt(0)" ::: "memory");
        }
    }
    __syncthreads();
}
constexpr int DM = 1024, SEQ = 16384, NBATCH = 2, MP = NBATCH * SEQ, DSEQ = 32, DBATCH = 16, MS = DBATCH * DSEQ, MT = MP + MS;
constexpr int DFF = 2816, PAST = 4096, SKV = PAST + DSEQ, FW_LD = 3 * DM + 16;
constexpr float LN_EPS = 1e-5f, DN_ALPHA = 1.4142135623730951f, LOG2E = 1.4426950408889634f;
constexpr float LAM_INIT = 0.35550906759096934f;
constexpr size_t O_YP = 0, O_YS = O_YP + (size_t)MP * DM, O_FKP = O_YS + (size_t)MS * DM, O_FVP = O_FKP + (size_t)MP * DM, O_FLP = O_FVP + (size_t)MP * DM,
                 O_DKP = O_FLP + (size_t)MP * 16, O_DVP = O_DKP + (size_t)MP * DM, O_FKS = O_DVP + (size_t)MP * DM, O_FVS = O_FKS + (size_t)MS * DM, O_FLS = O_FVS + (size_t)MS * DM,
                 O_DKS = O_FLS + (size_t)MS * 16, O_DVS = O_DKS + (size_t)MS * DM, O_END = O_DVS + (size_t)MS * DM;
static_assert(O_END == 170926080ull && O_FVP - O_FKP == (size_t)MP * DM && O_DVP - O_DKP == (size_t)MP * DM && O_FVS - O_FKS == (size_t)MS * DM && O_DVS - O_DKS == (size_t)MS * DM, "output map");
constexpr size_t MiB = 1u << 20;
constexpr size_t WS_CTL = 0, CTL_ZERO_BYTES = 64 * 1024;
constexpr size_t WS_WFIN = 2 * MiB, WS_WFOUT = 8 * MiB, WS_WDIN = 10 * MiB, WS_WDOUT = 16 * MiB, WS_WUP0 = 18 * MiB, WS_WUP1 = 29 * MiB, WS_WDN0 = 40 * MiB, WS_WDN1 = 46 * MiB;
constexpr size_t WS_GP = 52 * MiB, WS_GS = 54 * MiB;
constexpr size_t WS_XN = 64 * MiB;
constexpr size_t WS_Q = 130 * MiB, WS_K = 196 * MiB, WS_V = 262 * MiB;
constexpr size_t WS_H = 130 * MiB;
constexpr size_t WS_O1 = 328 * MiB, WS_O2 = 394 * MiB;
constexpr size_t WS_Y = 460 * MiB;
constexpr size_t WS_X = 592 * MiB;
constexpr size_t WS_END = 724 * MiB;
static_assert(WS_V - WS_K == WS_K - WS_Q && WS_WDN1 + (size_t)DM * DFF * 2 <= WS_GP && WS_GS + (size_t)256 * SKV * 4 <= WS_XN && WS_XN + (size_t)MT * DM * 2 <= WS_Q && WS_H + (size_t)MT * DFF * 2 <= WS_O1 && WS_V + (size_t)MT * DM * 2 <= WS_O1 && WS_X + (size_t)MT * DM * 4 <= WS_END, "d_ws map");
constexpr int CW_BAR = 4096, CW_NB = 8192, CW_QUEUE = 12288;
constexpr int RING_OFF = 0, RING_BYTES = 131072;
constexpr int PH_LDS = attn_body::ATTN_LDS_BYTES;
constexpr int LDSCTL_OFF = PH_LDS, MISC_OFF = LDSCTL_OFF + 320;
constexpr int LDS_BYTES = PH_LDS + 512;
static_assert(RING_BYTES <= PH_LDS && LDS_BYTES <= 160 * 1024, "LDS map");
constexpr int NWAVES = 8;
struct Args { const float* in[18]; float* out; unsigned char* ws; };
struct Frame {
    LAS unsigned char* lds;
    volatile LAS unsigned* MISC;
    gu32* ctl;
    int tid, lane, wave;
    int vcu, G;
};
__device__ __forceinline__ float wave_sum(float v) {
#pragma unroll
    for (int o = 1; o < 64; o <<= 1) v += __shfl_xor(v, o);
    return v;
}
template <int MODE>
__device__ __forceinline__ void p0_transpose_item(const float* W, int ldw, int K, int nblk, bf16* WT, LAS float* scr, int item, int lane) {
    const int kb = item / nblk, nb = item % nblk, k0 = 64 * kb, n0 = 32 * nb;
    int drow = n0;
    if (MODE == 1) { const int bj = n0 / DFF, rem = n0 % DFF; drow = 256 * (rem / 128) + 128 * bj + (rem % 128); }
#pragma unroll 8
    for (int i = 0; i < 32; ++i) { const int kk = 2 * i + (lane >> 5); scr[kk * 33 + (lane & 31)] = W[(size_t)(k0 + kk) * ldw + n0 + (lane & 31)]; }
    LDS_WAIT(); asm volatile("" ::: "memory");
    const int c = lane & 7;
#pragma unroll
    for (int j = 0; j < 4; ++j) { const int n = (lane >> 3) + 8 * j; const LAS float* s = scr + (8 * c) * 33 + n;
        v4u o; o.x = pk2(s[0 * 33], s[1 * 33]); o.y = pk2(s[2 * 33], s[3 * 33]); o.z = pk2(s[4 * 33], s[5 * 33]); o.w = pk2(s[6 * 33], s[7 * 33]);
        *(GAS v4u*)(WT + (size_t)(drow + n) * K + k0 + 8 * c) = o; }
    LDS_WAIT(); asm volatile("" ::: "memory");
}
constexpr int I_FIN = 16 * 96, I_SQ = 16 * 32, I_UP = 16 * 176, I_DN = 44 * 32;
constexpr int TI_A = I_FIN, TI_B = TI_A + I_FIN + I_SQ + I_UP + I_DN, TI_END = TI_B + I_SQ + I_UP + I_DN;
__device__ __forceinline__ void p0_item(const Args& A, unsigned char* ws, LAS float* scr, int it, int lane) {
    int r = it;
    if (r < I_FIN) { p0_transpose_item<0>(A.in[7], FW_LD, DM, 96, (bf16*)(ws + WS_WFIN), scr, r, lane); return; } r -= I_FIN;
    if (r < I_FIN) { p0_transpose_item<0>(A.in[10], 3 * DM, DM, 96, (bf16*)(ws + WS_WDIN), scr, r, lane); return; } r -= I_FIN;
    if (r < I_SQ) { p0_transpose_item<0>(A.in[9], DM, DM, 32, (bf16*)(ws + WS_WFOUT), scr, r, lane); return; } r -= I_SQ;
    if (r < I_UP) { p0_transpose_item<1>(A.in[14], 2 * DFF, DM, 176, (bf16*)(ws + WS_WUP0), scr, r, lane); return; } r -= I_UP;
    if (r < I_DN) { p0_transpose_item<0>(A.in[15], DM, DFF, 32, (bf16*)(ws + WS_WDN0), scr, r, lane); return; } r -= I_DN;
    if (r < I_SQ) { p0_transpose_item<0>(A.in[13], DM, DM, 32, (bf16*)(ws + WS_WDOUT), scr, r, lane); return; } r -= I_SQ;
    if (r < I_UP) { p0_transpose_item<1>(A.in[14] + (size_t)DM * 2 * DFF, 2 * DFF, DM, 176, (bf16*)(ws + WS_WUP1), scr, r, lane); return; } r -= I_UP;
    p0_transpose_item<0>(A.in[15] + (size_t)DFF * DM, DM, DFF, 32, (bf16*)(ws + WS_WDN1), scr, r, lane);
}
__device__ __forceinline__ void p0_tail_items(Frame& F, const Args& A, unsigned char* ws, int nlong, int lo, int hi) {
    const int rank = (int)blockIdx.x - nlong; if (rank < 0) return;
    __syncthreads();
    LAS float* scr = (LAS float*)(F.lds + F.wave * 16384);
    const int stride = (F.G - nlong) * NWAVES;
    for (int it = lo + rank * NWAVES + F.wave; it < hi; it += stride) p0_item(A, ws, scr, it, F.lane);
}
__device__ __forceinline__ void p0_prologue(Frame& F, const Args& A, unsigned char* ws, float* out) {
    LAS float* scr = (LAS float*)(F.lds + F.wave * 16384);
    const int gw = F.vcu * NWAVES + F.wave, NGW = F.G * NWAVES;
    for (int it = gw; it < TI_A; it += NGW) p0_item(A, ws, scr, it, F.lane);
    bf16* XN = (bf16*)(ws + WS_XN);
    for (int m0 = gw; m0 < MT; m0 += 2 * NGW) {
        f32x4 v[2][4];
#pragma unroll
        for (int h = 0; h < 2; ++h) { const int m = m0 + h * NGW; if (m < MT) { const float* xrow = m < MP ? A.in[0] + (size_t)m * DM : A.in[1] + (size_t)(m - MP) * DM;
            const GAS f32x4* xr = (const GAS f32x4*)xrow + F.lane;
#pragma unroll
            for (int j = 0; j < 4; ++j) v[h][j] = xr[64 * j]; } }
#pragma unroll
        for (int h = 0; h < 2; ++h) { const int m = m0 + h * NGW; if (m < MT) { GAS unsigned long long* o8 = (GAS unsigned long long*)(XN + (size_t)m * DM) + F.lane;
#pragma unroll
            for (int j = 0; j < 4; ++j) o8[64 * j] = (unsigned long long)pk2(v[h][j].x, v[h][j].y) | ((unsigned long long)pk2(v[h][j].z, v[h][j].w) << 32); } }
    }
    __syncthreads();
    __syncthreads();
    LAS float* wl = (LAS float*)F.lds;
    for (int slot = F.tid; slot < 4096; slot += NWAVES * 64) { const int j = slot >> 6, l = slot & 63; f32x4 v;
#pragma unroll
        for (int e = 0; e < 4; ++e) v[e] = A.in[7][(size_t)(16 * j + 4 * (l >> 4) + e) * FW_LD + 3 * DM + (l & 15)];
        *(LAS f32x4*)(wl + slot * 4) = v; }
    __syncthreads();
    { const int c = F.lane & 15, g = F.lane >> 4; const float bfv = A.in[8][c];
      float* lp = out + O_FLP; float* ls = out + O_FLS;
      for (int rg = gw; rg < MT / 16; rg += NGW) {
        const int row0 = rg * 16;
        const float* xr = (row0 < MP ? A.in[0] + (size_t)row0 * DM : A.in[1] + (size_t)(row0 - MP) * DM) + (size_t)c * DM + 4 * g;
        f32x4 a0 = {0.f, 0.f, 0.f, 0.f}, a1 = a0, a2 = a0, a3 = a0;
#pragma unroll 16
        for (int j = 0; j < 64; ++j) { const f32x4 a = *(const f32x4*)(xr + 16 * j); const f32x4 b = *(const LAS f32x4*)(wl + (j * 64 + F.lane) * 4);
            a0 = __builtin_amdgcn_mfma_f32_16x16x4f32(a[0], b[0], a0, 0, 0, 0); a1 = __builtin_amdgcn_mfma_f32_16x16x4f32(a[1], b[1], a1, 0, 0, 0);
            a2 = __builtin_amdgcn_mfma_f32_16x16x4f32(a[2], b[2], a2, 0, 0, 0); a3 = __builtin_amdgcn_mfma_f32_16x16x4f32(a[3], b[3], a3, 0, 0, 0); }
        const f32x4 s = (a0 + a1) + (a2 + a3);
#pragma unroll
        for (int r = 0; r < 4; ++r) { const float z = s[r] + bfv; const float lf = fminf(z, 0.f) - log1pf(expf(-fabsf(z))); const int row = row0 + 4 * g + r;
            if (row < MP) lp[(size_t)row * 16 + c] = lf; else ls[(size_t)(row - MP) * 16 + c] = lf; }
      } }
    __syncthreads();
}
__device__ __forceinline__ double block_excl_scan(double v, LAS double* sc, int lane, int wave) {
    double inc = v;
#pragma unroll
    for (int o = 1; o < 64; o <<= 1) { const double t = __shfl_up(inc, o); if (lane >= o) inc += t; }
    if (lane == 63) sc[wave] = inc;
    __syncthreads();
    double base = 0.0;
#pragma unroll
    for (int w = 0; w < NWAVES; ++w) if (w < wave) base += sc[w];
    __syncthreads();
    return base + inc - v;
}
__device__ __forceinline__ void p1_scan(Frame& F, const Args& A, unsigned char* ws, const float* out) {
    LAS double* sc = (LAS double*)F.lds;
    for (int sq = F.vcu; sq < 256; sq += F.G) {
        const int s = sq >> 4, h = sq & 15; const float* cl = A.in[4] + (size_t)s * PAST * 16 + h; const float* nl = out + O_FLS + (size_t)s * DSEQ * 16 + h;
        float* G = (float*)(ws + WS_GS) + (size_t)sq * SKV;
        const int j0 = F.tid * 9; double sum = 0.0;
        for (int i = 0; i < 9; ++i) { const int j = j0 + i; if (j < SKV) sum += (double)(j < PAST ? cl[(size_t)j * 16] : nl[(size_t)(j - PAST) * 16]); }
        double run = block_excl_scan(sum, sc, F.lane, F.wave);
        for (int i = 0; i < 9; ++i) { const int j = j0 + i; if (j < SKV) { run += (double)(j < PAST ? cl[(size_t)j * 16] : nl[(size_t)(j - PAST) * 16]); G[j] = (float)(-run * 1.4426950408889634); } }
    }
    for (int sq = F.vcu; sq < 32; sq += F.G) {
        const int b = sq >> 4, h = sq & 15; const float* pl = out + O_FLP + (size_t)b * SEQ * 16 + h;
        float* G = (float*)(ws + WS_GP) + (size_t)sq * SEQ;
        const int j0 = F.tid * 32; double sum = 0.0;
        for (int i = 0; i < 32; ++i) sum += (double)pl[(size_t)(j0 + i) * 16];
        double run = block_excl_scan(sum, sc, F.lane, F.wave);
        for (int i = 0; i < 32; ++i) { run += (double)pl[(size_t)(j0 + i) * 16]; G[j0 + i] = (float)(-run * 1.4426950408889634); }
    }
    __syncthreads();
}
__device__ __forceinline__ void unpk8(const v4u w, float (&f)[8]) {
#pragma unroll
    for (int i = 0; i < 4; ++i) { f[2 * i] = __uint_as_float(w[i] << 16); f[2 * i + 1] = __uint_as_float(w[i] & 0xffff0000u); }
}
template <bool FINAL>
__device__ __forceinline__ void ln_finish(Frame& F, float (&v)[16], const f32x4 (&gv)[4], const f32x4 (&bv)[4], v4u* xr, float* xo) {
    float s = 0.f;
#pragma unroll
    for (int i = 0; i < 16; ++i) s += v[i];
    const float mean = wave_sum(s) * (1.f / DM); float s2 = 0.f;
#pragma unroll
    for (int i = 0; i < 16; ++i) { v[i] -= mean; s2 += v[i] * v[i]; }
    const float rstd = 1.f / sqrtf(wave_sum(s2) * (1.f / DM) + LN_EPS);
#pragma unroll
    for (int j = 0; j < 2; ++j) {
        f32x4 o0, o1;
#pragma unroll
        for (int i = 0; i < 4; ++i) { o0[i] = v[8 * j + i] * rstd * gv[2 * j][i] + bv[2 * j][i]; o1[i] = v[8 * j + 4 + i] * rstd * gv[2 * j + 1][i] + bv[2 * j + 1][i]; }
        if (FINAL) { float* o = xo + 8 * F.lane + 512 * j; __builtin_nontemporal_store(o0, (f32x4*)o); __builtin_nontemporal_store(o1, (f32x4*)(o + 4)); }
        else { v4u w; w.x = pk2(o0[0], o0[1]); w.y = pk2(o0[2], o0[3]); w.z = pk2(o1[0], o1[1]); w.w = pk2(o1[2], o1[3]); xr[64 * j] = w; }
    }
}
__device__ __forceinline__ void ln_mix(const v4u x0, const v4u x1, const v4u y0, const v4u y1, float (&v)[16]) {
    float xf[8], yf[8];
    unpk8(x0, xf); unpk8(y0, yf);
#pragma unroll
    for (int i = 0; i < 8; ++i) v[i] = xf[i] * DN_ALPHA + yf[i];
    unpk8(x1, xf); unpk8(y1, yf);
#pragma unroll
    for (int i = 0; i < 8; ++i) v[8 + i] = xf[i] * DN_ALPHA + yf[i];
}
template <bool FINAL, int NSLAB>
__device__ __forceinline__ void ln_phase(Frame& F, bf16* XN, const bf16* Y, const float* slab, const float* gam, const float* bet, float* xo_p, float* xo_s) {
    const int gw = F.vcu * NWAVES + F.wave, NGW = F.G * NWAVES;
    f32x4 gv[4], bv[4];
#pragma unroll
    for (int j = 0; j < 2; ++j) { gv[2 * j] = ((const f32x4*)gam)[2 * F.lane + 128 * j]; gv[2 * j + 1] = ((const f32x4*)gam)[2 * F.lane + 128 * j + 1];
                                  bv[2 * j] = ((const f32x4*)bet)[2 * F.lane + 128 * j]; bv[2 * j + 1] = ((const f32x4*)bet)[2 * F.lane + 128 * j + 1]; }
    for (int m = gw; m < MP; m += 2 * NGW) {
        const int mb = m + NGW;
        v4u* xa = (v4u*)(XN + (size_t)m * DM) + F.lane; const v4u* ya = (const v4u*)(Y + (size_t)m * DM) + F.lane;
        v4u* xb = (v4u*)(XN + (size_t)mb * DM) + F.lane; const v4u* yb = (const v4u*)(Y + (size_t)mb * DM) + F.lane;
        const bool hb = mb < MP;
        const v4u xa0 = xa[0], xa1 = xa[64], ya0 = ya[0], ya1 = ya[64];
        v4u xb0 = xa0, xb1 = xa1, yb0 = ya0, yb1 = ya1;
        if (hb) { xb0 = xb[0]; xb1 = xb[64]; yb0 = yb[0]; yb1 = yb[64]; }
        float v[16];
        ln_mix(xa0, xa1, ya0, ya1, v); ln_finish<FINAL>(F, v, gv, bv, xa, xo_p + (size_t)m * DM);
        if (hb) { ln_mix(xb0, xb1, yb0, yb1, v); ln_finish<FINAL>(F, v, gv, bv, xb, xo_p + (size_t)mb * DM); }
    }
    for (int m = MP + gw; m < MT; m += NGW) {
        v4u* xr = (v4u*)(XN + (size_t)m * DM) + F.lane;
        const v4u x0 = xr[0], x1 = xr[64];
        float xf[8], v[16];
        unpk8(x0, xf);
#pragma unroll
        for (int i = 0; i < 8; ++i) v[i] = xf[i] * DN_ALPHA;
        unpk8(x1, xf);
#pragma unroll
        for (int i = 0; i < 8; ++i) v[8 + i] = xf[i] * DN_ALPHA;
        const float* sp = slab + (size_t)(m - MP) * DM + 8 * F.lane;
#pragma unroll
        for (int sl = 0; sl < NSLAB; ++sl) { const f32x4 a0 = *(const f32x4*)(sp + (size_t)sl * MS * DM), a1 = *(const f32x4*)(sp + (size_t)sl * MS * DM + 4), a2 = *(const f32x4*)(sp + (size_t)sl * MS * DM + 512), a3 = *(const f32x4*)(sp + (size_t)sl * MS * DM + 516);
#pragma unroll
            for (int i = 0; i < 4; ++i) { v[i] += a0[i]; v[4 + i] += a1[i]; v[8 + i] += a2[i]; v[12 + i] += a3[i]; } }
        ln_finish<FINAL>(F, v, gv, bv, xr, xo_s + (size_t)(m - MP) * DM);
    }
}
__device__ __forceinline__ void diff_combine(Frame& F, const bf16* O1, const bf16* O2, const float* lamp, const float* subg, bf16* XN) {
    const int gw = F.vcu * NWAVES + F.wave, NGW = F.G * NWAVES;
    const float sa = wave_sum(lamp[F.lane] * lamp[64 + F.lane]), sb = wave_sum(lamp[128 + F.lane] * lamp[192 + F.lane]);
    const float lam = expf(sa) - expf(sb) + LAM_INIT;
    float gsc[16];
#pragma unroll
    for (int i = 0; i < 16; ++i) gsc[i] = subg[(16 * F.lane + i) & 127] * (1.0f - LAM_INIT);
    for (int m = gw; m < MT; m += NGW) {
        const v4u* a = (const v4u*)(O1 + (size_t)m * DM + 16 * F.lane); const v4u* b = (const v4u*)(O2 + (size_t)m * DM + 16 * F.lane);
        const v4u a0 = a[0], a1 = a[1], b0 = b[0], b1 = b[1];
        float o[16]; float ss = 0.f;
#pragma unroll
        for (int i = 0; i < 8; ++i) { const unsigned wa = i < 4 ? a0[i & 3] : a1[i & 3], wb = i < 4 ? b0[i & 3] : b1[i & 3];
            o[2 * i] = __uint_as_float(wa << 16) - lam * __uint_as_float(wb << 16); o[2 * i + 1] = __uint_as_float(wa & 0xffff0000u) - lam * __uint_as_float(wb & 0xffff0000u);
            ss += o[2 * i] * o[2 * i] + o[2 * i + 1] * o[2 * i + 1]; }
        ss += __shfl_xor(ss, 1); ss += __shfl_xor(ss, 2); ss += __shfl_xor(ss, 4);
        const float rs = 1.f / sqrtf(ss * (1.f / 128.f) + LN_EPS);
        v4u w0, w1;
        w0.x = pk2(o[0] * rs * gsc[0], o[1] * rs * gsc[1]); w0.y = pk2(o[2] * rs * gsc[2], o[3] * rs * gsc[3]); w0.z = pk2(o[4] * rs * gsc[4], o[5] * rs * gsc[5]); w0.w = pk2(o[6] * rs * gsc[6], o[7] * rs * gsc[7]);
        w1.x = pk2(o[8] * rs * gsc[8], o[9] * rs * gsc[9]); w1.y = pk2(o[10] * rs * gsc[10], o[11] * rs * gsc[11]); w1.z = pk2(o[12] * rs * gsc[12], o[13] * rs * gsc[13]); w1.w = pk2(o[14] * rs * gsc[14], o[15] * rs * gsc[15]);
        v4u* d = (v4u*)(XN + (size_t)m * DM + 16 * F.lane); d[0] = w0; d[1] = w1;
    }
}
namespace samp {
constexpr float SAMPLE_SKIP_TH = 44.f;
using attn_body::bf16x8; using attn_body::f32x16; using attn_body::crow;
typedef float f32x4s __attribute__((ext_vector_type(4)));
__device__ __forceinline__ unsigned cvtpk(float lo, float hi) { return attn_body::cvtpk_s(lo, hi); }
__device__ __forceinline__ bf16x8 pack8(const f32x4s a, const f32x4s b) { attn_body::u32x4 w; w.x = cvtpk(a[0], a[1]); w.y = cvtpk(a[2], a[3]); w.z = cvtpk(b[0], b[1]); w.w = cvtpk(b[2], b[3]); return __builtin_bit_cast(bf16x8, w); }
#define SMFMA(a, b, c) __builtin_amdgcn_mfma_f32_32x32x16_bf16(a, b, c, 0, 0, 0)
template <int NDB>
__device__ __forceinline__ void softmax_upd(f32x16& p0, f32x16& p1, float& m, float& l, f32x16 (&o)[NDB]) {
    float rm = fmaxf(p0[0], p1[0]);
#pragma unroll
    for (int r = 1; r < 16; ++r) rm = fmaxf(rm, fmaxf(p0[r], p1[r]));
    rm = fmaxf(rm, __shfl_xor(rm, 32));
    const float mn = fmaxf(m, rm), al = __builtin_amdgcn_exp2f(m - mn); float sum = 0.f;
#pragma unroll
    for (int r = 0; r < 16; ++r) { p0[r] = __builtin_amdgcn_exp2f(p0[r] - mn); p1[r] = __builtin_amdgcn_exp2f(p1[r] - mn); sum += p0[r] + p1[r]; }
    l = l * al + sum; m = mn;
#pragma unroll
    for (int d = 0; d < NDB; ++d)
#pragma unroll
        for (int r = 0; r < 16; ++r) o[d][r] *= al;
}
__device__ __forceinline__ bf16x8 pfrag(const f32x16& p, int s) { attn_body::u32x4 w; w.x = cvtpk(p[8 * s], p[8 * s + 1]); w.y = cvtpk(p[8 * s + 2], p[8 * s + 3]); w.z = cvtpk(p[8 * s + 4], p[8 * s + 5]); w.w = cvtpk(p[8 * s + 6], p[8 * s + 7]); return __builtin_bit_cast(bf16x8, w); }

template <int MODE>
__device__ __forceinline__ void sample_unit(Frame& F, int u, const bf16* Qb, const bf16* Kb, const bf16* Vb, bf16* Ob1, bf16* Ob2, const float* cK, const float* cV, const float* Gs) {
    constexpr int DV = MODE == 0 ? 64 : 128, NDB = DV / 32;
    const int lane = F.lane, r32 = lane & 31, hi = lane >> 5, wid = F.wave;
    const int s = u >> 4; int kcol, vcol; float sl2 = 0.f; bf16* Ob = Ob1;
    if (MODE == 0) { const int h = u & 15; kcol = h * 64; vcol = h * 64; }
    else { const int head = (u >> 1) & 7, map = u & 1; kcol = head * 128 + map * 64; vcol = head * 128; sl2 = exp2f(-(float)(head + 1)) * LOG2E; Ob = map ? Ob2 : Ob1; }
    const size_t srow = (size_t)MP + 32 * s;
    bf16x8 qr[4];
#pragma unroll
    for (int d0 = 0; d0 < 4; ++d0) qr[d0] = *(const bf16x8*)(Qb + (srow + r32) * DM + kcol + d0 * 16 + hi * 8);
    float m = -1e30f, l = 0.f; f32x16 o[NDB];
#pragma unroll
    for (int d = 0; d < NDB; ++d) o[d] = f32x16{};
    const float* kbase = cK + (size_t)s * PAST * DM + kcol; const float* vbase = cV + (size_t)s * PAST * DM + vcol;
    const float* gs = Gs + (size_t)u * SKV;
    if (wid == 0) {
        f32x16 p0, p1;
#pragma unroll
        for (int r = 0; r < 16; ++r) p1[r] = -INFINITY;
#pragma unroll
        for (int g = 0; g < 4; ++g) {
            f32x4s b0 = {0.f, 0.f, 0.f, 0.f};
            if (MODE == 0) b0 = *(const f32x4s*)(gs + PAST + 8 * g + 4 * hi);
#pragma unroll
            for (int i = 0; i < 4; ++i) { const int kv = 8 * g + 4 * hi + i;
                if (MODE == 0) p0[4 * g + i] = kv > r32 ? -INFINITY : b0[i];
                else p0[4 * g + i] = sl2 * (float)(kv <= r32 ? kv : 2 * r32 - kv); }
        }
#pragma unroll
        for (int d0 = 0; d0 < 4; ++d0) { const bf16x8 ka = *(const bf16x8*)(Kb + (srow + r32) * DM + kcol + 16 * d0 + 8 * hi); p0 = SMFMA(ka, qr[d0], p0); }
        softmax_upd<NDB>(p0, p1, m, l, o);
#pragma unroll
        for (int ks = 0; ks < 2; ++ks) {
            const bf16x8 pb = pfrag(p0, ks);
            const bf16* vp = Vb + (srow + 16 * ks + 4 * hi) * DM + vcol + r32;
#pragma unroll
            for (int d = 0; d < NDB; ++d) {
                attn_body::u32x4 w;
#pragma unroll
                for (int jj = 0; jj < 4; ++jj) { const int j = 2 * jj; const unsigned lo = vp[(size_t)(8 * (j >> 2) + (j & 3)) * DM + 32 * d], hh = vp[(size_t)(8 * ((j + 1) >> 2) + ((j + 1) & 3)) * DM + 32 * d]; w[jj] = lo | (hh << 16); }
                o[d] = SMFMA(__builtin_bit_cast(bf16x8, w), pb, o[d]);
            }
        }
    }
#pragma unroll 1
    for (int T = PAST / 64 - 1 - wid; T >= 0; T -= NWAVES) {
        f32x16 p0, p1;
#pragma unroll
        for (int g = 0; g < 4; ++g) {
            if (MODE == 0) { const f32x4s b0 = *(const f32x4s*)(gs + 64 * T + 8 * g + 4 * hi), b1 = *(const f32x4s*)(gs + 64 * T + 32 + 8 * g + 4 * hi);
#pragma unroll
                for (int i = 0; i < 4; ++i) { p0[4 * g + i] = b0[i]; p1[4 * g + i] = b1[i]; } }
            else {
#pragma unroll
                for (int i = 0; i < 4; ++i) { const int kv = 64 * T + 8 * g + 4 * hi + i; p0[4 * g + i] = sl2 * (float)(kv - PAST); p1[4 * g + i] = sl2 * (float)(kv + 32 - PAST); } }
        }
#pragma unroll
        for (int d0 = 0; d0 < 4; ++d0) {
            const float* k0p = kbase + (size_t)(64 * T + r32) * DM + 16 * d0 + 8 * hi; const float* k1p = k0p + (size_t)32 * DM;
            const bf16x8 ka = pack8(*(const f32x4s*)k0p, *(const f32x4s*)(k0p + 4)), kb = pack8(*(const f32x4s*)k1p, *(const f32x4s*)(k1p + 4));
            p0 = SMFMA(ka, qr[d0], p0); p1 = SMFMA(kb, qr[d0], p1);
        }
        { float rm = fmaxf(p0[0], p1[0]);
#pragma unroll
          for (int r = 1; r < 16; ++r) rm = fmaxf(rm, fmaxf(p0[r], p1[r]));
          rm = fmaxf(rm, __shfl_xor(rm, 32));
          if (__all(rm < m - SAMPLE_SKIP_TH)) continue; }
        softmax_upd<NDB>(p0, p1, m, l, o);
#pragma unroll
        for (int hf = 0; hf < 2; ++hf)
#pragma unroll
            for (int ks = 0; ks < 2; ++ks) {
                const bf16x8 pb = pfrag(hf ? p1 : p0, ks);
                const float* vp = vbase + (size_t)(64 * T + 32 * hf + 16 * ks + 4 * hi) * DM + r32;
#pragma unroll
                for (int d = 0; d < NDB; ++d) {
                    f32x4s va, vb;
#pragma unroll
                    for (int j = 0; j < 4; ++j) { va[j] = vp[(size_t)j * DM + 32 * d]; vb[j] = vp[(size_t)(8 + j) * DM + 32 * d]; }
                    o[d] = SMFMA(pack8(va, vb), pb, o[d]);
                }
            }
    }
    l += __shfl_xor(l, 32);
    LAS float* ml = (LAS float*)F.lds;
    LAS float* ob = (LAS float*)(F.lds + 2048);
    if (hi == 0) { ml[(wid * 32 + r32) * 2] = m; ml[(wid * 32 + r32) * 2 + 1] = l; }
#pragma unroll
    for (int d = 0; d < NDB; ++d)
#pragma unroll
        for (int g = 0; g < 4; ++g) { f32x4s v = {o[d][4 * g], o[d][4 * g + 1], o[d][4 * g + 2], o[d][4 * g + 3]}; *(LAS f32x4s*)(ob + (size_t)(wid * 32 + r32) * DV + 32 * d + 8 * g + 4 * hi) = v; }
    __syncthreads();
    { constexpr int PER = DV / 16; const int q = F.tid >> 4, dg = F.tid & 15;
      float mw[NWAVES], M = -1e30f;
#pragma unroll
      for (int w = 0; w < NWAVES; ++w) { mw[w] = ml[(w * 32 + q) * 2]; M = fmaxf(M, mw[w]); }
      float L = 0.f, acc[PER];
#pragma unroll
      for (int i = 0; i < PER; ++i) acc[i] = 0.f;
#pragma unroll
      for (int w = 0; w < NWAVES; ++w) { const float wg = __builtin_amdgcn_exp2f(mw[w] - M); L += wg * ml[(w * 32 + q) * 2 + 1];
#pragma unroll
          for (int i = 0; i < PER; ++i) acc[i] += wg * ob[(size_t)(w * 32 + q) * DV + dg * PER + i]; }
      const float rl = 1.f / L;
      bf16* op = Ob + (srow + q) * DM + vcol + dg * PER;
#pragma unroll
      for (int i = 0; i < PER; i += 2) *(unsigned*)(op + i) = pk2(acc[i] * rl, acc[i + 1] * rl);
    }
    __syncthreads();
}
#undef SMFMA
}
constexpr float SKIP_TH = 44.f;
struct DiagPart { float mneg, qq; };
__device__ __forceinline__ DiagPart diag_part(Frame& F, const attn_body::bf16* Qc, const attn_body::bf16* Kc, long row0) {
    const int r32 = F.lane & 31, hi = F.lane >> 5;
    const attn_body::bf16* qp = Qc + (row0 + F.wave * 32 + r32) * DM + hi * 32; const attn_body::bf16* kp = Kc + (row0 + F.wave * 32 + r32) * DM + hi * 32;
    float d = 0.f, qq = 0.f;
#pragma unroll
    for (int c = 0; c < 4; ++c) { const bf16x8 qv = *(const bf16x8*)(qp + 8 * c), kv = *(const bf16x8*)(kp + 8 * c);
#pragma unroll
        for (int e = 0; e < 8; ++e) { const float qf = __uint_as_float((unsigned)(unsigned short)qv[e] << 16); d += qf * __uint_as_float((unsigned)(unsigned short)kv[e] << 16); qq += qf * qf; } }
    d += __shfl_xor(d, 32); qq += __shfl_xor(qq, 32);
    float mneg = fmaxf(0.f, -d);
#pragma unroll
    for (int o = 16; o >= 1; o >>= 1) { mneg = fmaxf(mneg, __shfl_xor(mneg, o)); qq = fmaxf(qq, __shfl_xor(qq, o)); }
    DiagPart r; r.mneg = mneg; r.qq = qq; return r;
}
__device__ __forceinline__ DiagPart diag_bound(Frame& F, volatile LAS int* qs, DiagPart p) {
    __syncthreads();
    if (F.lane == 0) { qs[8 + F.wave] = (int)__float_as_uint(p.mneg); qs[16 + F.wave] = (int)__float_as_uint(p.qq); }
    __syncthreads();
    float m = 0.f, q = 0.f;
#pragma unroll
    for (int w = 0; w < NWAVES; ++w) { m = fmaxf(m, __uint_as_float((unsigned)qs[8 + w])); q = fmaxf(q, __uint_as_float((unsigned)qs[16 + w])); }
    DiagPart r; r.mneg = m * 1.001f + 0.01f; r.qq = q * 1.0001f; return r;
}
template <int NC>
__device__ __forceinline__ void kv_out_block(Frame& F, const attn_body::bf16* src, float* dst) {
    constexpr int CPR = NC / 8, NI = NC / 16;
    v4u wv[NI];
#pragma unroll
    for (int i = 0; i < NI; ++i) { const int c = F.tid + i * NWAVES * 64; const int row = c / CPR, ch = c % CPR; wv[i] = *(const v4u*)(src + (size_t)row * DM + ch * 8); }
#pragma unroll
    for (int i = 0; i < NI; ++i) { const int c = F.tid + i * NWAVES * 64; const int row = c / CPR, ch = c % CPR; const v4u w = wv[i]; f32x4 a, b2;
        a[0] = __uint_as_float(w.x << 16); a[1] = __uint_as_float(w.x & 0xffff0000u); a[2] = __uint_as_float(w.y << 16); a[3] = __uint_as_float(w.y & 0xffff0000u);
        b2[0] = __uint_as_float(w.z << 16); b2[1] = __uint_as_float(w.z & 0xffff0000u); b2[2] = __uint_as_float(w.w << 16); b2[3] = __uint_as_float(w.w & 0xffff0000u);
        float* o = dst + (size_t)row * DM + ch * 8; __builtin_nontemporal_store(a, (f32x4*)o); __builtin_nontemporal_store(b2, (f32x4*)(o + 4)); }
}
template <int MODE>
__device__ __forceinline__ void attn_phase(Frame& F, unsigned char* lds_raw, const Args& A, unsigned char* ws, int qoff) {
    using abf = attn_body::bf16;
    constexpr int NVH = 32, NUNITS = 64 * NVH;
    LAS float* tab = (LAS float*)(F.lds + attn_body::LDS_TAB);
    gu32* ctr = F.ctl + CW_QUEUE + qoff;
    const unsigned* nb = (const unsigned*)(F.ctl + CW_NB + MODE * 128);
    if (threadIdx.x == 0) ((volatile LAS int*)(F.lds + LDSCTL_OFF))[0] = (int)__hip_atomic_fetch_add(ctr, 1u, __ATOMIC_RELAXED, __HIP_MEMORY_SCOPE_AGENT);
    for (;;) {
        F.tid = threadIdx.x; asm volatile("" : "+v"(F.tid)); F.lane = F.tid & 63; F.wave = __builtin_amdgcn_readfirstlane(F.tid >> 6);
        unsigned char* wl = ws; asm volatile("" : "+s"(wl));
        const abf* Qb = (const abf*)(wl + WS_Q); const abf* Kb = (const abf*)(wl + WS_K); const abf* Vb = (const abf*)(wl + WS_V);
        volatile LAS int* qs = (volatile LAS int*)(F.lds + LDSCTL_OFF) + (F.tid >> 20);
        __syncthreads();
        const int n = __builtin_amdgcn_readfirstlane(qs[0]);
        if (n >= NUNITS) break;
        const int qb = 63 - n / NVH, vhid = n % NVH, q0 = qb * 256;
        if (MODE == 0) {
            const int b = vhid >> 4, h = vhid & 15;
            const float* G = (const float*)(wl + WS_GP) + (size_t)vhid * SEQ;
            const float gq0 = G[q0]; const float gend = (F.tid < 4 * qb) ? G[64 * F.tid + 63] : 3.0e38f;
            const float bq2 = __uint_as_float(nb[(0 * 2 + b) * 32 + 2 * h]) + __uint_as_float(nb[(0 * 2 + b) * 32 + 2 * h + 1]);
            const float bk2 = __uint_as_float(nb[(1 * 2 + b) * 32 + 2 * h]) + __uint_as_float(nb[(1 * 2 + b) * 32 + 2 * h + 1]);
            const DiagPart dg = diag_bound(F, qs, diag_part(F, Qb + h * 64, Kb + h * 64, (long)b * SEQ + q0));
            const float thr = gq0 - 1.02f * sqrtf(fminf(bq2, dg.qq) * bk2) - dg.mneg - SKIP_TH;
            if (F.tid < 256) { const bool pred = gend < thr; const unsigned long long bm = __ballot(pred); if (F.lane == 0) qs[1 + F.wave] = __popcll(bm); }
            __syncthreads();
            const int t0 = __builtin_amdgcn_readfirstlane((qs[1] + qs[2] + qs[3] + qs[4]) & ~1);
            for (int i = 16 * t0 + F.tid; i < (q0 + 256) / 4; i += NWAVES * 64) *(LAS f32x4*)(tab + 4 * i) = *(const f32x4*)(G + 4 * i) - gq0;
            __syncthreads();
            attn_body::attn_unit<0, 24>((long)b * SEQ, qb, t0, Qb + h * 64, Kb + h * 64, Vb + h * 64, (abf*)(wl + WS_Q) + h * 64, (char*)lds_raw, 0.f);
            F.tid = threadIdx.x; asm volatile("" : "+v"(F.tid));
            int nn = 0; if (F.tid == 0) nn = (int)__hip_atomic_fetch_add(ctr, 1u, __ATOMIC_RELAXED, __HIP_MEMORY_SCOPE_AGENT);
            kv_out_block<64>(F, Kb + ((long)b * SEQ + q0) * DM + h * 64, A.out + O_FKP + ((size_t)b * SEQ + q0) * DM + h * 64);
            kv_out_block<64>(F, Vb + ((long)b * SEQ + q0) * DM + h * 64, A.out + O_FVP + ((size_t)b * SEQ + q0) * DM + h * 64);
            if (F.tid == 0) qs[0] = nn;
        } else {
            const int b = vhid >> 4, head = (vhid >> 1) & 7, map = vhid & 1;
            const float sl2 = exp2f(-(float)(head + 1)) * LOG2E;
            const int c32 = 4 * head + 2 * map;
            const DiagPart dg = diag_bound(F, qs, diag_part(F, Qb + head * 128 + map * 64, Kb + head * 128 + map * 64, (long)b * SEQ + q0));
            const float bq2 = __uint_as_float(nb[(0 * 2 + b) * 32 + c32]) + __uint_as_float(nb[(0 * 2 + b) * 32 + c32 + 1]);
            const float bk2 = __uint_as_float(nb[(1 * 2 + b) * 32 + c32]) + __uint_as_float(nb[(1 * 2 + b) * 32 + c32 + 1]);
            const float xlim = (float)(q0 - 63) - (1.02f * sqrtf(fminf(bq2, dg.qq) * bk2) + dg.mneg + SKIP_TH) / sl2;
            int t0 = xlim <= 0.f ? 0 : (int)(xlim * (1.f / 64.f));
            t0 = __builtin_amdgcn_readfirstlane(min(t0, 4 * qb) & ~1);
            const int qcol = head * 128 + map * 64, vcol = head * 128;
            attn_body::attn_unit_d128<24>((long)b * SEQ, qb, t0, Qb + qcol, Kb + qcol, Vb + vcol, (abf*)(wl + (map ? WS_O2 : WS_O1)) + vcol, (char*)lds_raw, 2.f * sl2);
            F.tid = threadIdx.x; asm volatile("" : "+v"(F.tid));
            int nn = 0; if (F.tid == 0) nn = (int)__hip_atomic_fetch_add(ctr, 1u, __ATOMIC_RELAXED, __HIP_MEMORY_SCOPE_AGENT);
            kv_out_block<64>(F, Kb + ((long)b * SEQ + q0) * DM + qcol, A.out + O_DKP + ((size_t)b * SEQ + q0) * DM + qcol);
            if (map == 0) kv_out_block<128>(F, Vb + ((long)b * SEQ + q0) * DM + vcol, A.out + O_DVP + ((size_t)b * SEQ + q0) * DM + vcol);
            if (F.tid == 0) qs[0] = nn;
        }
    }
    __syncthreads();
    F.tid = threadIdx.x; asm volatile("" : "+v"(F.tid)); F.lane = F.tid & 63; F.wave = __builtin_amdgcn_readfirstlane(F.tid >> 6);
    for (int u = F.vcu; u < 256; u += F.G) {
        if (MODE == 0) samp::sample_unit<0>(F, u, (const bf16*)(ws + WS_Q), (const bf16*)(ws + WS_K), (const bf16*)(ws + WS_V), (bf16*)(ws + WS_Q), (bf16*)(ws + WS_Q), A.in[2], A.in[3], (const float*)(ws + WS_GS));
        else samp::sample_unit<1>(F, u, (const bf16*)(ws + WS_Q), (const bf16*)(ws + WS_K), (const bf16*)(ws + WS_V), (bf16*)(ws + WS_O1), (bf16*)(ws + WS_O2), A.in[5], A.in[6], nullptr);
    }
}

#ifndef NPHASE
#define NPHASE 99
#endif
__global__ void __launch_bounds__(NWAVES * 64, 2) mk_fwd(Args args) {
    extern __shared__ __attribute__((aligned(16))) unsigned char lds[];
    Frame F;
    F.lds = (LAS unsigned char*)lds;
    F.MISC = (volatile LAS unsigned*)(F.lds + MISC_OFF);
    F.tid = threadIdx.x; F.lane = F.tid & 63; F.wave = __builtin_amdgcn_readfirstlane(F.tid >> 6);
    F.G = gridDim.x; { const int bx = blockIdx.x; F.vcu = (F.G % 8 == 0) ? (bx % 8) * (F.G / 8) + bx / 8 : bx; }
    unsigned char* ws = args.ws; const Args& A = args; float* out = args.out;
    F.ctl = (gu32*)(ws + WS_CTL);
    for (int u = F.tid; u < (LDS_BYTES - LDSCTL_OFF) / 4; u += NWAVES * 64) ((LAS unsigned*)(F.lds + LDSCTL_OFF))[u] = 0u;
    __syncthreads();
    XcdBarrier bar = xcd_barrier_post((unsigned*)(F.ctl + CW_BAR), F.MISC + 8);
#define GRID_BAR() do { xcd_barrier(bar); F.tid = threadIdx.x; asm volatile("" : "+v"(F.tid)); F.lane = F.tid & 63; F.wave = __builtin_amdgcn_readfirstlane(F.tid >> 6); } while (0)
    bf16* XN = (bf16*)(ws + WS_XN); bf16* QB = (bf16*)(ws + WS_Q); bf16* KB = (bf16*)(ws + WS_K); bf16* VB = (bf16*)(ws + WS_V); bf16* HB = (bf16*)(ws + WS_H);
    bf16* Y = (bf16*)(ws + WS_Y); float* YS = (float*)(ws + WS_X);

    p0_prologue(F, A, ws, out);
    GRID_BAR();
#if NPHASE >= 1
    p1_scan(F, A, ws, out);
    { pg8::Gemm g{XN, (const bf16*)(ws + WS_WFIN), MT, 3 * DM, DM}; pg8::StaticOrder S; S.init(MT, 3 * DM, F.G, (int)blockIdx.x, DM / 64);
      pg8::EpiQKV E{QB, (WS_K - WS_Q) / 2, out + O_FKP, out + O_FKS, attn_body::C2, (unsigned*)(F.ctl + CW_NB)};
      pg8::gemm_phase<pg8::EpiQKV, pg8::StaticOrder, true, true>(F.lds + RING_OFF, g, S, E); }
    p0_tail_items(F, A, ws, (MT / 256) * (3 * DM / 256) % F.G, TI_A, TI_B);
    GRID_BAR();
#endif
#if NPHASE >= 2
    attn_phase<0>(F, lds, A, ws, 0);
    GRID_BAR();
#endif
#if NPHASE >= 3
    { pg8::Gemm g{QB, (const bf16*)(ws + WS_WFOUT), MT, DM, DM}; pg8::SplitOrder S; S.init(MP, DM, F.G, (int)blockIdx.x, DM / 64, 4);
      pg8::EpiYSplit E{Y, YS, DM, 4};
      pg8::gemm_phase<pg8::EpiYSplit, pg8::SplitOrder, true, true>(F.lds + RING_OFF, g, S, E); }
    GRID_BAR();
    ln_phase<false, 4>(F, XN, Y, YS, A.in[16], A.in[17], nullptr, nullptr);
    GRID_BAR();
#endif
#if NPHASE >= 4
    { pg8::Gemm g{XN, (const bf16*)(ws + WS_WUP0), MT, 2 * DFF, DM}; pg8::StaticOrder S; S.init(MT, 2 * DFF, F.G, (int)blockIdx.x, DM / 64);
      pg8::EpiSwiGLU E{HB, DFF};
      pg8::gemm_phase<pg8::EpiSwiGLU, pg8::StaticOrder, true, true>(F.lds + RING_OFF, g, S, E); }
    GRID_BAR();
    { pg8::Gemm g{HB, (const bf16*)(ws + WS_WDN0), MT, DM, DFF}; pg8::SplitOrder S; S.init(MP, DM, F.G, (int)blockIdx.x, DFF / 64, 4);
      pg8::EpiYSplit E{Y, YS, DM, 4};
      pg8::gemm_phase<pg8::EpiYSplit, pg8::SplitOrder, true, true>(F.lds + RING_OFF, g, S, E); }
    GRID_BAR();
    ln_phase<false, 11>(F, XN, Y, YS, A.in[16] + DM, A.in[17] + DM, nullptr, nullptr);
    GRID_BAR();
#endif
#if NPHASE >= 5
    { pg8::Gemm g{XN, (const bf16*)(ws + WS_WDIN), MT, 3 * DM, DM}; pg8::StaticOrder S; S.init(MT, 3 * DM, F.G, (int)blockIdx.x, DM / 64);
      pg8::EpiQKV E{QB, (WS_K - WS_Q) / 2, out + O_DKP, out + O_DKS, attn_body::C2, (unsigned*)(F.ctl + CW_NB + 128)};
      pg8::gemm_phase<pg8::EpiQKV, pg8::StaticOrder, true, true>(F.lds + RING_OFF, g, S, E); }
    p0_tail_items(F, A, ws, (MT / 256) * (3 * DM / 256) % F.G, TI_B, TI_END);
    GRID_BAR();
#endif
#if NPHASE >= 6
    attn_phase<1>(F, lds, A, ws, 64);
    GRID_BAR();
    diff_combine(F, (const bf16*)(ws + WS_O1), (const bf16*)(ws + WS_O2), A.in[11], A.in[12], QB);
    GRID_BAR();
#endif
#if NPHASE >= 7
    { pg8::Gemm g{QB, (const bf16*)(ws + WS_WDOUT), MT, DM, DM}; pg8::SplitOrder S; S.init(MP, DM, F.G, (int)blockIdx.x, DM / 64, 4);
      pg8::EpiYSplit E{Y, YS, DM, 4};
      pg8::gemm_phase<pg8::EpiYSplit, pg8::SplitOrder, true, true>(F.lds + RING_OFF, g, S, E); }
    GRID_BAR();
    ln_phase<false, 4>(F, XN, Y, YS, A.in[16] + 2 * DM, A.in[17] + 2 * DM, nullptr, nullptr);
    GRID_BAR();
    { pg8::Gemm g{XN, (const bf16*)(ws + WS_WUP1), MT, 2 * DFF, DM}; pg8::StaticOrder S; S.init(MT, 2 * DFF, F.G, (int)blockIdx.x, DM / 64);
      pg8::EpiSwiGLU E{HB, DFF};
      pg8::gemm_phase<pg8::EpiSwiGLU, pg8::StaticOrder, true, true>(F.lds + RING_OFF, g, S, E); }
    GRID_BAR();
    { pg8::Gemm g{HB, (const bf16*)(ws + WS_WDN1), MT, DM, DFF}; pg8::SplitOrder S; S.init(MP, DM, F.G, (int)blockIdx.x, DFF / 64, 4);
      pg8::EpiYSplit E{Y, YS, DM, 4};
      pg8::gemm_phase<pg8::EpiYSplit, pg8::SplitOrder, true, true>(F.lds + RING_OFF, g, S, E); }
    GRID_BAR();
    ln_phase<true, 11>(F, XN, Y, YS, A.in[16] + 3 * DM, A.in[17] + 3 * DM, out + O_YP, out + O_YS);
#endif
}

extern "C" void kernel_launch(void* const* d_in, const int* in_sizes, int n_in, void* d_out, int out_size, void* d_ws, size_t ws_size, hipStream_t stream) {
    static int grid = 0;
    if (grid == 0) {
        if (n_in != 18 || (size_t)out_size != O_END || ws_size < WS_END) { fprintf(stderr, "kernel_launch: unexpected shapes (n_in %d out %d ws %zu); nothing launched\n", n_in, out_size, ws_size); grid = -1; return; }
        int dev = 0, cus = 0, per_cu = 0;
        if (hipGetDevice(&dev) != hipSuccess || hipDeviceGetAttribute(&cus, hipDeviceAttributeMultiprocessorCount, dev) != hipSuccess) { grid = -1; return; }
        if (hipFuncSetAttribute((const void*)mk_fwd, hipFuncAttributeMaxDynamicSharedMemorySize, LDS_BYTES) != hipSuccess) { fprintf(stderr, "kernel_launch: hipFuncSetAttribute failed\n"); grid = -1; return; }
        if (hipOccupancyMaxActiveBlocksPerMultiprocessor(&per_cu, (const void*)mk_fwd, NWAVES * 64, LDS_BYTES) != hipSuccess || per_cu < 1) { fprintf(stderr, "kernel_launch: occupancy query says %d blocks per CU\n", per_cu); }
        (void)hipGetLastError();
        grid = cus;
        if (grid != 256) { fprintf(stderr, "kernel_launch: built for 256 CUs, found %d; nothing launched\n", grid); grid = -1; return; }
    }
    if (grid < 0) return;
    if (hipMemsetAsync((char*)d_ws + WS_CTL, 0, CTL_ZERO_BYTES, stream) != hipSuccess) return;
    Args a{};
    for (int i = 0; i < 18; ++i) a.in[i] = (const float*)d_in[i];
    a.out = (float*)d_out; a.ws = (unsigned char*)d_ws;
    hipLaunchKernelGGL(mk_fwd, dim3(grid), dim3(NWAVES * 64), LDS_BYTES, stream, a);
}
```
